# Optimizing an MI355X kernel written in HIP

```python
import math
import jax, jax.numpy as jnp
from jax import lax
import numpy as np

D_MODEL = 2048
BATCH = 2
SEQ = 4096
DEPTH = 4

D_MIX = D_MODEL
D_DIFF = D_MIX // 2
D_HGRN = D_MIX - D_DIFF
DIFF_HEAD_DIM = 128
DIFF_QK_DIM = DIFF_HEAD_DIM // 2
N_DIFF_HEADS = D_DIFF // DIFF_HEAD_DIM
HGRN_HEAD_DIM = 128
N_HGRN_HEADS = D_HGRN // HGRN_HEAD_DIM
HGRN_CHUNK = 64
Q_BLOCK = 128
NUM_BUCKETS = 32
MAX_DISTANCE = 128
N_EXPERTS = 16
N_GROUPS = 4
EXPERTS_PER_GROUP = N_EXPERTS // N_GROUPS
TOP_K = 2
D_EXPERT = D_MODEL // 4
N_MOD = 6
EPS = 1e-6
IN_COLS = 3 * D_DIFF + 4 * D_HGRN
SPLITS = [D_DIFF, 2 * D_DIFF, 3 * D_DIFF, 3 * D_DIFF + D_HGRN, 3 * D_DIFF + 2 * D_HGRN, 3 * D_DIFF + 3 * D_HGRN]

kernel_name = "hybrid_diffattn_hgrn2_groupedmoe_adaln"


def rms_norm(x, g):
    xf = x.astype(jnp.float32)
    y = xf * lax.rsqrt(jnp.mean(xf * xf, axis=-1, keepdims=True) + EPS)
    return (y * g.astype(jnp.float32)).astype(x.dtype)


def t5_bucket(n):
    max_exact = NUM_BUCKETS // 2
    nf = jnp.maximum(n, 1).astype(jnp.float32)
    large = max_exact + (jnp.log(nf / max_exact) / math.log(MAX_DISTANCE / max_exact)
                         * (NUM_BUCKETS - max_exact)).astype(jnp.int32)
    large = jnp.minimum(large, NUM_BUCKETS - 1)
    return jnp.where(n < max_exact, n, large)


def diff_attention(q, k, v, rel_table, lam, lambda_init, subln_g):
    B, S = q.shape[0], q.shape[1]
    nb = S // Q_BLOCK
    H2 = 2 * N_DIFF_HEADS
    qf = q.astype(jnp.float32) * (DIFF_QK_DIM ** -0.5)
    kf = k.astype(jnp.float32)
    vf = v.astype(jnp.float32)
    lam = lam.astype(jnp.float32)
    q_blocks = qf.reshape(B, nb, Q_BLOCK, H2, DIFF_QK_DIM).transpose(1, 0, 2, 3, 4)
    kpos = jnp.arange(S)

    def one_block(args):
        qb, blk = args
        qpos = blk * Q_BLOCK + jnp.arange(Q_BLOCK)
        rel = qpos[:, None] - kpos[None, :]
        causal = rel >= 0
        bias = rel_table.astype(jnp.float32)[t5_bucket(jnp.maximum(rel, 0))]
        s = jnp.einsum('bqhd,bkhd->bhqk', qb, kf) + bias.transpose(2, 0, 1)[None]
        s = jnp.where(causal[None, None], s, -1e30)
        p = jax.nn.softmax(s, axis=-1).reshape(B, N_DIFF_HEADS, 2, Q_BLOCK, S)
        a = p[:, :, 0] - lam * p[:, :, 1]
        return jnp.einsum('bhqk,bkhd->bqhd', a, vf)

    o = lax.map(one_block, (q_blocks, jnp.arange(nb)))
    o = o.transpose(1, 0, 2, 3, 4).reshape(B, S, N_DIFF_HEADS, DIFF_HEAD_DIM)
    o = rms_norm(o, subln_g) * (1.0 - lambda_init)
    return o.reshape(B, S, D_DIFF)


def hgrn2(q, f_raw, v, g, lb, norm_g):
    B, S, _ = q.shape
    H, dk, C = N_HGRN_HEADS, HGRN_HEAD_DIM, HGRN_CHUNK
    nc = S // C
    lbf = lb.astype(jnp.float32)
    fr = f_raw.astype(jnp.float32)
    f = lbf + (1.0 - lbf) * jax.nn.sigmoid(fr)
    log_f = jnp.log(jnp.maximum(f, jnp.finfo(jnp.float32).tiny))
    k = (1.0 - lbf) * jax.nn.sigmoid(-fr)

    def chunks(t):
        return t.astype(jnp.float32).reshape(B, nc, C, H, dk).transpose(1, 0, 3, 2, 4)

    xs = (chunks(q), chunks(k), chunks(v), chunks(log_f))
    causal = jnp.tril(jnp.ones((C, C), dtype=bool))[:, :, None]

    def step(state, inp):
        qc, kc, vc, lc = inp
        b = jnp.cumsum(lc, axis=2)
        b_end = b[:, :, -1:, :]
        o_inter = jnp.einsum('bhtd,bhdv->bhtv', qc * jnp.exp(b), state)
        rel = b[:, :, :, None, :] - b[:, :, None, :, :]
        decay = jnp.where(causal, jnp.exp(jnp.minimum(rel, 0.0)), 0.0)
        scores = jnp.einsum('bhtd,bhsd,bhtsd->bhts', qc, kc, decay)
        o_intra = jnp.einsum('bhts,bhsv->bhtv', scores, vc)
        new_state = (jnp.exp(b_end[:, :, 0, :])[..., None] * state
                     + jnp.einsum('bhsd,bhsv->bhdv', kc * jnp.exp(b_end - b), vc))
        return new_state, o_inter + o_intra

    state0 = jnp.zeros((B, H, dk, dk), jnp.float32)
    _, o = lax.scan(step, state0, xs)
    o = o.transpose(1, 0, 3, 2, 4).reshape(B, S, H, dk)
    o = rms_norm(o, norm_g).reshape(B, S, D_HGRN)
    return o * jax.nn.silu(g.astype(jnp.float32))


def grouped_moe(h, w_router, b_router, w_gate, w_up, w_down):
    B, S, D = h.shape
    t = h.reshape(B * S, D)
    logits = (t @ w_router).astype(jnp.float32) + b_router.astype(jnp.float32)
    probs = jax.nn.softmax(logits, axis=-1)
    grouped = probs.reshape(-1, N_GROUPS, EXPERTS_PER_GROUP)
    group_score = lax.top_k(grouped, TOP_K)[0].sum(-1)
    group_sel = jnp.argmax(group_score, axis=-1)
    expert_mask = jnp.repeat(jax.nn.one_hot(group_sel, N_GROUPS, dtype=jnp.bool_), EXPERTS_PER_GROUP, axis=-1)
    masked = jnp.where(expert_mask, probs, -1.0)
    top_vals, top_idx = lax.top_k(masked, TOP_K)
    weights = top_vals / jnp.sum(top_vals, axis=-1, keepdims=True)
    gates = jnp.sum(jax.nn.one_hot(top_idx, N_EXPERTS, dtype=jnp.float32) * weights[..., None], axis=-2)
    hg = jnp.einsum('td,edf->tef', t, w_gate)
    hu = jnp.einsum('td,edf->tef', t, w_up)
    act = jax.nn.silu(hg) * hu * gates[..., None].astype(hg.dtype)
    y = jnp.einsum('tef,efd->td', act, w_down)
    return y.reshape(B, S, D)


def setup_inputs(seed: int = 0) -> dict:
    key = jax.random.key(seed)
    ks = jax.random.split(key, 24)
    f32 = jnp.float32
    nrm = lambda k, shape, s: jax.random.normal(k, shape, f32) * s
    return {
        "x": nrm(ks[0], (BATCH, SEQ, D_MODEL), 1.0),
        "c": nrm(ks[1], (BATCH, D_MODEL), 1.0),
        "w_in": nrm(ks[2], (DEPTH, D_MODEL, IN_COLS), D_MODEL ** -0.5),
        "w_out": nrm(ks[3], (DEPTH, D_MIX, D_MODEL), D_MIX ** -0.5),
        "attn_norm": 1.0 + nrm(ks[4], (DEPTH, D_MODEL), 0.02),
        "ffn_norm": 1.0 + nrm(ks[5], (DEPTH, D_MODEL), 0.02),
        "w_ada": nrm(ks[6], (DEPTH, D_MODEL, N_MOD * D_MODEL), 0.2 * D_MODEL ** -0.5),
        "b_ada": nrm(ks[7], (DEPTH, N_MOD * D_MODEL), 0.02),
        "lambda_q1": nrm(ks[8], (DEPTH, DIFF_QK_DIM), 0.1),
        "lambda_k1": nrm(ks[9], (DEPTH, DIFF_QK_DIM), 0.1),
        "lambda_q2": nrm(ks[10], (DEPTH, DIFF_QK_DIM), 0.1),
        "lambda_k2": nrm(ks[11], (DEPTH, DIFF_QK_DIM), 0.1),
        "diff_subln": 1.0 + nrm(ks[12], (DEPTH, DIFF_HEAD_DIM), 0.02),
        "hgrn_lb": 1.0 + nrm(ks[13], (DEPTH, D_HGRN), 0.1),
        "hgrn_norm": 1.0 + nrm(ks[14], (DEPTH, HGRN_HEAD_DIM), 0.02),
        "rel_bias": nrm(ks[15], (NUM_BUCKETS, 2 * N_DIFF_HEADS), 0.5),
        "w_router": nrm(ks[16], (D_MODEL, N_EXPERTS), D_MODEL ** -0.5),
        "b_router": nrm(ks[17], (N_EXPERTS,), 0.01),
        "w_gate": nrm(ks[18], (DEPTH, N_EXPERTS, D_MODEL, D_EXPERT), D_MODEL ** -0.5),
        "w_up": nrm(ks[19], (DEPTH, N_EXPERTS, D_MODEL, D_EXPERT), D_MODEL ** -0.5),
        "w_down": nrm(ks[20], (DEPTH, N_EXPERTS, D_EXPERT, D_MODEL), D_EXPERT ** -0.5),
        "final_norm": 1.0 + nrm(ks[21], (D_MODEL,), 0.02),
    }


def reference(x, c, w_in, w_out, attn_norm, ffn_norm, w_ada, b_ada, lambda_q1, lambda_k1, lambda_q2, lambda_k2,
              diff_subln, hgrn_lb, hgrn_norm, rel_bias, w_router, b_router, w_gate, w_up, w_down, final_norm):
    B, S, _ = x.shape
    lb_soft = jax.nn.softmax(hgrn_lb.astype(jnp.float32), axis=0)
    lower_bounds = jnp.maximum(jnp.cumsum(lb_soft, axis=0) - lb_soft[0:1], 0.0)
    c_act = jax.nn.silu(c)
    for l in range(DEPTH):
        mod = c_act @ w_ada[l] + b_ada[l]
        shift1, scale1, gate1, shift2, scale2, gate2 = jnp.split(mod, N_MOD, axis=-1)
        h = rms_norm(x, attn_norm[l]) * (1.0 + scale1[:, None]) + shift1[:, None]
        proj = h @ w_in[l]
        qd, kd, vd, qh, fh, ih, gh = jnp.split(proj, SPLITS, axis=-1)
        lambda_init = 0.8 - 0.6 * math.exp(-0.3 * l)
        lam = (jnp.exp(jnp.sum(lambda_q1[l].astype(jnp.float32) * lambda_k1[l].astype(jnp.float32)))
               - jnp.exp(jnp.sum(lambda_q2[l].astype(jnp.float32) * lambda_k2[l].astype(jnp.float32)))
               + lambda_init)
        attn_out = diff_attention(qd.reshape(B, S, 2 * N_DIFF_HEADS, DIFF_QK_DIM),
                                  kd.reshape(B, S, 2 * N_DIFF_HEADS, DIFF_QK_DIM),
                                  vd.reshape(B, S, N_DIFF_HEADS, DIFF_HEAD_DIM),
                                  rel_bias, lam, lambda_init, diff_subln[l])
        hgrn_out = hgrn2(qh, fh, ih, gh, lower_bounds[l], hgrn_norm[l])
        mixed = jnp.concatenate([attn_out.astype(h.dtype), hgrn_out.astype(h.dtype)], axis=-1) @ w_out[l]
        x = x + gate1[:, None] * mixed
        h2 = rms_norm(x, ffn_norm[l]) * (1.0 + scale2[:, None]) + shift2[:, None]
        x = x + gate2[:, None] * grouped_moe(h2, w_router, b_router, w_gate[l], w_up[l], w_down[l])
    return rms_norm(x, final_norm)
```

```cpp
#include <hip/hip_runtime.h>
#include <cstdio>
#include <cstdint>
#include <cmath>

constexpr int NB = 2, S = 4096, D = 2048, T = NB * S, DEPTH = 4;
constexpr int INC = 7168, NMOD = 6, MODW = NMOD * D;
constexpr int NE = 16, DE = 512;
constexpr float EPS = 1e-6f;
constexpr int C_QD = 0, C_KD = 1024, C_VD = 2048, C_QH = 3072, C_FH = 4096, C_IH = 5120, C_GH = 6144;
constexpr float LOG2E = 1.4426950408889634f;
constexpr float QSCALE = 0.125f * LOG2E;
constexpr int NCH = S / 64;

typedef unsigned short bf16_t;
typedef short bf16x8 __attribute__((ext_vector_type(8)));
typedef float f32x4 __attribute__((ext_vector_type(4)));
typedef float f32x16 __attribute__((ext_vector_type(16)));
typedef unsigned u32x4 __attribute__((ext_vector_type(4)));
typedef unsigned u32x2 __attribute__((ext_vector_type(2)));
#define GAS __attribute__((address_space(1)))
#define LAS __attribute__((address_space(3)))

__device__ const unsigned char T5B[128] = {0, 1, 2, 3, 4, 5, 6, 7, 8, 9, 10, 11, 12, 13, 14, 15, 16, 16, 16, 17, 17, 18, 18, 18, 19, 19, 19, 20, 20, 20, 20, 21, 21, 21, 21, 22, 22, 22, 22, 22, 23, 23, 23, 23, 23, 23, 24, 24, 24, 24, 24, 24, 25, 25, 25, 25, 25, 25, 25, 26, 26, 26, 26, 26, 26, 26, 26, 27, 27, 27, 27, 27, 27, 27, 27, 27, 27, 28, 28, 28, 28, 28, 28, 28, 28, 28, 28, 29, 29, 29, 29, 29, 29, 29, 29, 29, 29, 29, 29, 30, 30, 30, 30, 30, 30, 30, 30, 30, 30, 30, 30, 30, 30, 31, 31, 31, 31, 31, 31, 31, 31, 31, 31, 31, 31, 31, 31, 31};

__device__ __forceinline__ float wave_sum(float v) {
#pragma unroll
    for (int o = 1; o < 64; o <<= 1) v += __shfl_xor(v, o);
    return v;
}
__device__ __forceinline__ float wave_max(float v) {
#pragma unroll
    for (int o = 1; o < 64; o <<= 1) v = fmaxf(v, __shfl_xor(v, o));
    return v;
}
__device__ __forceinline__ float block_sum256(float v, float* red) {
    v = wave_sum(v);
    __syncthreads();
    if ((threadIdx.x & 63) == 0) red[threadIdx.x >> 6] = v;
    __syncthreads();
    return red[0] + red[1] + red[2] + red[3];
}
__device__ __forceinline__ float block_max256(float v, float* red) {
    v = wave_max(v);
    __syncthreads();
    if ((threadIdx.x & 63) == 0) red[threadIdx.x >> 6] = v;
    __syncthreads();
    return fmaxf(fmaxf(red[0], red[1]), fmaxf(red[2], red[3]));
}
__device__ __forceinline__ float sigmoidf_(float x) { return 1.f / (1.f + expf(-x)); }
__device__ __forceinline__ float siluf_(float x) { return x / (1.f + expf(-x)); }
__device__ __forceinline__ unsigned f2bf(float f) { unsigned u = __builtin_bit_cast(unsigned, f); return (u + 0x7fffu + ((u >> 16) & 1u)) >> 16; }
__device__ __forceinline__ unsigned pk2(float lo, float hi) { return f2bf(lo) | (f2bf(hi) << 16); }
__device__ __forceinline__ float bf2f(unsigned short h) { return __builtin_bit_cast(float, (unsigned)h << 16); }
__device__ __forceinline__ float bflo(unsigned w) { return __builtin_bit_cast(float, w << 16); }
__device__ __forceinline__ float bfhi(unsigned w) { return __builtin_bit_cast(float, w & 0xffff0000u); }

__device__ __forceinline__ void hgrn_gate(float fr, float lbv, float& logf, float& kk) {
    const float s1 = 1.f / (1.f + expf(-fr)), s2 = 1.f / (1.f + expf(fr));
    const float f = lbv + (1.f - lbv) * s1;
    logf = __logf(fmaxf(f, 1.17549435e-38f)); kk = (1.f - lbv) * s2;
}
#ifndef MK_ONE
#define MK_ONE 0
#endif
namespace pg8 {
constexpr int BM = 256, BK = 64, HALF = 128, HTB = HALF * BK * 2  , STAGE_BYTES = 8 * HTB, NXCD = 8, WGM = 8;
__host__ __device__ __forceinline__ int lds_byte(int r, int c) { const int st = (r >> 4) * 2 + (c >> 5), rr = r & 15, cc = c & 31, ob = rr * 64 + cc * 2; return st * 1024 + (ob ^ (((ob >> 9) & 1) << 5)); }
__host__ __device__ __forceinline__ void stage_rc(int b, int& R, int& C) { const int st = b / 1024, sb = b % 1024, swz = sb ^ (((sb >> 9) & 1) << 5); R = (st >> 1) * 16 + swz / 64; C = (st & 1) * 32 + (swz % 64) / 2; }
__host__ __device__ __forceinline__ int perm32(int rho) { const int n = rho >> 4, i = rho & 15; return 8 * (i >> 2) + 4 * n + (i & 3); }

struct Unit { int pm, pn, e, ct, r0, n; };
struct Gemm { const bf16_t* A; const bf16_t* Bt; int K; };

struct StaticOrder {
    int nM, nN, nwg, G, c;
    __device__ void init(int M, int N, int G_, int c_) { nM = M / BM; nN = N / BM; nwg = nM * nN; G = G_; c = c_; }
    __device__ bool next(int i, Unit& u) const {
        const long L = (long)i * G + c; if (L >= nwg) return false;
        int wgid = (int)L; { const int q = nwg / NXCD, r = nwg % NXCD, xcd = wgid % NXCD, off = wgid / NXCD; wgid = (xcd < r ? xcd * (q + 1) : r * (q + 1) + (xcd - r) * q) + off; }
        const int nig = WGM * nN, gid = wgid / nig, fm = gid * WGM, gsz = (nM - fm) < WGM ? (nM - fm) : WGM;
        u.pm = fm + ((wgid % nig) % gsz); u.pn = (wgid % nig) / gsz; u.e = 0; u.ct = u.pn; u.r0 = 0; u.n = 0; return true;
    }
    __device__ __forceinline__ int arow(const Unit&, int) const { return 0; }
};
struct MoeOrder {
    const LAS int* tb; const int* rowtok; int ncol, G, c;
    __device__ bool next(int i, Unit& u) const {
        const int L = i * G + c; if (L >= tb[16] * ncol) return false;
        const int rt = L / ncol, ct = L - rt * ncol; int e = 0;
        while (tb[e + 1] <= rt) ++e;
        u.e = e; u.ct = ct; u.pm = rt; u.pn = e * ncol + ct; u.r0 = (rt - tb[e]) * 256; u.n = tb[17 + e]; return true;
    }
    __device__ __forceinline__ int arow(const Unit& u, int r) const { const int lr = u.r0 + r; return lr < u.n ? (rowtok[u.e * T + lr] & 0x7fffffff) : 0; }
};

__device__ __forceinline__ unsigned cvt_pk_bf16(float lo, float hi) { unsigned r; asm volatile("v_cvt_pk_bf16_f32 %0, %1, %2" : "=v"(r) : "v"(lo), "v"(hi)); return r; }

struct EpiProj {
    static constexpr bool PERM = true;
    bf16_t* P; float* LF; const float* lb;
    __device__ __forceinline__ void operator()(const f32x4 (&acc)[2][2][4][2], const Unit& u, int wr, int wc, int fr, int fq) const {
        const int row0 = u.pm * BM + wr * 64 + fr, colt = u.pn * BM, type = colt >> 10, col0 = colt + wc * 32 + 8 * fq;
#pragma unroll
        for (int ai = 0; ai < 2; ++ai)
#pragma unroll
            for (int m = 0; m < 4; ++m) { const int row = row0 + ai * HALF + m * 16; bf16_t* rowp = P + (size_t)row * INC + col0;
#pragma unroll
                for (int bj = 0; bj < 2; ++bj) { f32x4 v0 = acc[ai][bj][m][0], v1 = acc[ai][bj][m][1];
                    if (type == 0) { v0 = v0 * QSCALE; v1 = v1 * QSCALE; }
                    else if (type == 4) { const int ci = col0 + bj * HALF - C_FH; const f32x4 l0 = *(const f32x4*)(lb + ci), l1 = *(const f32x4*)(lb + ci + 4); f32x4 g0, g1;
#pragma unroll
                        for (int j = 0; j < 4; ++j) { float lf, kk; hgrn_gate(v0[j], l0[j], lf, kk); g0[j] = lf; v0[j] = kk; hgrn_gate(v1[j], l1[j], lf, kk); g1[j] = lf; v1[j] = kk; }
                        float* lfp = LF + (size_t)row * 1024 + ci; *(f32x4*)lfp = g0; *(f32x4*)(lfp + 4) = g1; }
                    else if (type == 6) {
#pragma unroll
                        for (int j = 0; j < 4; ++j) { v0[j] = siluf_(v0[j]); v1[j] = siluf_(v1[j]); } }
                    u32x4 w; w.x = cvt_pk_bf16(v0[0], v0[1]); w.y = cvt_pk_bf16(v0[2], v0[3]); w.z = cvt_pk_bf16(v1[0], v1[1]); w.w = cvt_pk_bf16(v1[2], v1[3]);
                    *(u32x4*)(rowp + bj * HALF) = w; } }
    }
};
struct EpiResid {
    static constexpr bool PERM = false;
    float* X; const float* gate;
    __device__ __forceinline__ void operator()(const f32x4 (&acc)[2][2][4][2], const Unit& u, int wr, int wc, int fr, int fq) const {
        const int row0 = u.pm * BM + wr * 64 + fr, col0 = u.pn * BM + wc * 32 + 4 * fq; const int b = (u.pm * BM) / S;
        f32x4 gv[2][2];
#pragma unroll
        for (int bj = 0; bj < 2; ++bj)
#pragma unroll
            for (int n = 0; n < 2; ++n) gv[bj][n] = *(const f32x4*)(gate + b * MODW + col0 + bj * HALF + n * 16);
#pragma unroll
        for (int ai = 0; ai < 2; ++ai)
#pragma unroll
            for (int m = 0; m < 4; ++m) { float* rowp = X + (size_t)(row0 + ai * HALF + m * 16) * D + col0;
#pragma unroll
                for (int bj = 0; bj < 2; ++bj)
#pragma unroll
                    for (int n = 0; n < 2; ++n) { f32x4* p = (f32x4*)(rowp + bj * HALF + n * 16); *p = *p + gv[bj][n] * acc[ai][bj][m][n]; } }
    }
};
struct EpiMoeUp {
    static constexpr bool PERM = true;
    bf16_t* act; const float* roww;
    __device__ __forceinline__ void operator()(const f32x4 (&acc)[2][2][4][2], const Unit& u, int wr, int wc, int fr, int fq) const {
        const int col0 = u.ct * 128 + wc * 32 + 8 * fq;
#pragma unroll
        for (int ai = 0; ai < 2; ++ai)
#pragma unroll
            for (int m = 0; m < 4; ++m) { const int r = ai * HALF + wr * 64 + m * 16 + fr, lr = u.r0 + r;
                if (lr < u.n) { const float w = roww[u.e * T + lr]; const f32x4 g0 = acc[ai][0][m][0], g1 = acc[ai][0][m][1], u0 = acc[ai][1][m][0], u1 = acc[ai][1][m][1]; f32x4 a0, a1;
#pragma unroll
                    for (int j = 0; j < 4; ++j) { a0[j] = siluf_(g0[j]) * u0[j] * w; a1[j] = siluf_(g1[j]) * u1[j] * w; }
                    u32x4 o; o.x = cvt_pk_bf16(a0[0], a0[1]); o.y = cvt_pk_bf16(a0[2], a0[3]); o.z = cvt_pk_bf16(a1[0], a1[1]); o.w = cvt_pk_bf16(a1[2], a1[3]);
                    *(u32x4*)(act + (size_t)(u.pm * BM + r) * DE + col0) = o; } }
    }
};
struct EpiMoeDown {
    static constexpr bool PERM = false;
    float* X; bf16_t* Y1; const float* gate; const int* rowtok;
    __device__ __forceinline__ void operator()(const f32x4 (&acc)[2][2][4][2], const Unit& u, int wr, int wc, int fr, int fq) const {
        const int col0 = u.ct * BM + wc * 32 + 4 * fq;
#pragma unroll
        for (int ai = 0; ai < 2; ++ai)
#pragma unroll
            for (int m = 0; m < 4; ++m) { const int lr = u.r0 + ai * HALF + wr * 64 + m * 16 + fr;
                if (lr < u.n) { const int ts = rowtok[u.e * T + lr], tok = ts & 0x7fffffff; const float* gp = gate + (tok / S) * MODW + col0;
                    if (ts >= 0) { float* rowp = X + (size_t)tok * D + col0;
#pragma unroll
                        for (int bj = 0; bj < 2; ++bj)
#pragma unroll
                            for (int n = 0; n < 2; ++n) { f32x4* p = (f32x4*)(rowp + bj * HALF + n * 16); *p = *p + *(const f32x4*)(gp + bj * HALF + n * 16) * acc[ai][bj][m][n]; } }
                    else { bf16_t* rowp = Y1 + (size_t)tok * D + col0;
#pragma unroll
                        for (int bj = 0; bj < 2; ++bj)
#pragma unroll
                            for (int n = 0; n < 2; ++n) { const f32x4 v = *(const f32x4*)(gp + bj * HALF + n * 16) * acc[ai][bj][m][n]; u32x2 o; o.x = cvt_pk_bf16(v[0], v[1]); o.y = cvt_pk_bf16(v[2], v[3]);
                                *(u32x2*)(rowp + bj * HALF + n * 16) = o; } } } }
    }
};

template <class Epi, class Sched, bool GATHER = false>
__device__ __forceinline__ void gemm_phase(LAS unsigned char* lds, const Gemm g, const Sched& S, const Epi& E) {
    int tid_ = threadIdx.x; asm volatile("" : "+v"(tid_));
    const int tid = tid_, wid = __builtin_amdgcn_readfirstlane(tid >> 6), lane = tid & 63, wr = wid >> 2, wc = wid & 3, fr = lane & 15, fq = lane >> 4;
    const int K = g.K, nt = K / BK;
    unsigned voffA[2], voffB[2]; int RA[2], CA[2];
#pragma unroll
    for (int i = 0; i < 2; ++i) { int R, C; stage_rc(tid * 16 + i * 8192, R, C); const int Rb = Epi::PERM ? ((R & ~31) + perm32(R & 31)) : R;
        voffA[i] = (unsigned)(R * K + C) * 2u; voffB[i] = (unsigned)(Rb * K + C) * 2u; RA[i] = R; CA[i] = C; }
    const size_t kstep = (size_t)(BK * 2);
    const size_t hstep = (size_t)HALF * K * 2;
    const size_t tstep = 2 * hstep;
    const unsigned ldsw = (unsigned)wid * 1024u;
    const int aoff = lds_byte(wr * 64 + fr, fq * 8), boff = lds_byte(wc * 32 + fr, fq * 8);
#define PG8_SA(b, h) (((b) * 2 + (h)) * HTB)
#define PG8_SB(b, h) ((4 + (b) * 2 + (h)) * HTB)
#define PG8_STAGE(bufoff, gbase, voff) do { _Pragma("unroll") for (int _i = 0; _i < 2; ++_i) \
        __builtin_amdgcn_global_load_lds((const unsigned*)((const char*)(gbase) + (voff)[_i]), (LAS unsigned*)(lds + (bufoff) + ldsw + _i * 8192), 16, 0, 0); } while (0)
#define PG8_STAGE_A(b, h, base, GO) do { if constexpr (GATHER) { PG8_STAGE(PG8_SA(b, h), base, GO[h]); } else { PG8_STAGE(PG8_SA(b, h), (base) + (h) * hstep, voffA); } } while (0)
#define PG8_GSET(GO, U) do { if constexpr (GATHER) { _Pragma("unroll") for (int _h = 0; _h < 2; ++_h) _Pragma("unroll") for (int _i = 0; _i < 2; ++_i) \
        GO[_h][_i] = (unsigned)(S.arow(U, _h * HALF + RA[_i]) * K + CA[_i]) * 2u; } } while (0)
#define PG8_LDA(dst, b, h) do { _Pragma("unroll") for (int m = 0; m < 4; ++m) _Pragma("unroll") for (int k = 0; k < 2; ++k) dst[m][k] = *(const LAS bf16x8*)(lds + PG8_SA(b, h) + aoff + m * 2048 + k * 1024); } while (0)
#define PG8_LDB(dst, b, h) do { _Pragma("unroll") for (int n = 0; n < 2; ++n) _Pragma("unroll") for (int k = 0; k < 2; ++k) dst[n][k] = *(const LAS bf16x8*)(lds + PG8_SB(b, h) + boff + n * 2048 + k * 1024); } while (0)
#define PG8_MMA(ai, bj, At, Bt) do { __builtin_amdgcn_s_setprio(1); _Pragma("unroll") for (int m = 0; m < 4; ++m) _Pragma("unroll") for (int n = 0; n < 2; ++n) _Pragma("unroll") for (int k = 0; k < 2; ++k) \
        acc[ai][bj][m][n] = __builtin_amdgcn_mfma_f32_16x16x32_bf16(Bt[n][k], At[m][k], acc[ai][bj][m][n], 0, 0, 0); __builtin_amdgcn_s_setprio(0); } while (0)
#define PG8_WAIT_V(n) asm volatile("s_waitcnt vmcnt(" #n ")" ::: "memory")
#define PG8_WAIT_L(n) asm volatile("s_waitcnt lgkmcnt(" #n ")" ::: "memory")
#define PG8_BAR __builtin_amdgcn_s_barrier()
#define PG8_SCHED __builtin_amdgcn_sched_barrier(0)
    Unit cur, nxt; int ui = 0;
    if (!S.next(0, cur)) return;
    f32x4 acc[2][2][4][2];
#pragma unroll
    for (int a = 0; a < 2; ++a)
#pragma unroll
        for (int b = 0; b < 2; ++b)
#pragma unroll
            for (int m = 0; m < 4; ++m)
#pragma unroll
                for (int n = 0; n < 2; ++n) acc[a][b][m][n] = (f32x4){0.f, 0.f, 0.f, 0.f};
    bf16x8 At[4][2], B0[2][2], B1[2][2];
    unsigned gcur[2][2] = {{0u, 0u}, {0u, 0u}}, gnxt[2][2] = {{0u, 0u}, {0u, 0u}}, gsel[2][2] = {{0u, 0u}, {0u, 0u}};
    const char* cA = GATHER ? (const char*)g.A : (const char*)g.A + (size_t)cur.pm * tstep; const char* cB = (const char*)g.Bt + (size_t)cur.pn * tstep;
    PG8_GSET(gcur, cur);
    PG8_STAGE(PG8_SB(0, 0), cB, voffB); PG8_STAGE(PG8_SB(0, 1), cB + hstep, voffB); PG8_STAGE_A(0, 0, cA, gcur); PG8_STAGE_A(0, 1, cA, gcur);
    if (wr == 1) PG8_BAR;
    PG8_WAIT_V(2); PG8_BAR;
    PG8_STAGE(PG8_SB(1, 0), cB + kstep, voffB); PG8_STAGE_A(1, 0, cA + kstep, gcur); PG8_STAGE(PG8_SB(1, 1), cB + hstep + kstep, voffB);
    PG8_WAIT_V(6); PG8_BAR;
    for (;;) {
        const bool has_next = S.next(ui + 1, nxt);
        const char* nA = GATHER ? (const char*)g.A : (has_next ? (const char*)g.A + (size_t)nxt.pm * tstep : cA); const char* nB = has_next ? (const char*)g.Bt + (size_t)nxt.pn * tstep : cB;
        if constexpr (GATHER) { if (has_next) { PG8_GSET(gnxt, nxt); } else {
#pragma unroll
            for (int h = 0; h < 2; ++h)
#pragma unroll
                for (int i = 0; i < 2; ++i) gnxt[h][i] = gcur[h][i]; } }
        for (int t = 0; t < nt; t += 2) {
            const bool last = (t == nt - 2);
            const char* a1 = cA + (size_t)(t + 1) * kstep;
            const char* a2 = last ? nA : cA + (size_t)(t + 2) * kstep; const char* b2 = last ? nB : cB + (size_t)(t + 2) * kstep;
            const char* a3 = a2 + kstep; const char* b3 = b2 + kstep;
            if constexpr (GATHER) {
#pragma unroll
                for (int h = 0; h < 2; ++h)
#pragma unroll
                    for (int i = 0; i < 2; ++i) gsel[h][i] = last ? gnxt[h][i] : gcur[h][i]; }
            PG8_LDB(B0, 0, 0); PG8_LDB(B1, 0, 1); PG8_SCHED; PG8_LDA(At, 0, 0); PG8_STAGE_A(1, 1, a1, gcur);
            PG8_WAIT_V(8); PG8_WAIT_L(0); PG8_BAR; PG8_MMA(0, 0, At, B0); PG8_MMA(0, 1, At, B1); PG8_BAR; PG8_SCHED;
            PG8_LDA(At, 0, 1); PG8_STAGE(PG8_SB(0, 0), b2, voffB); PG8_STAGE(PG8_SB(0, 1), b2 + hstep, voffB); PG8_STAGE_A(0, 0, a2, gsel);
            PG8_WAIT_V(8); PG8_WAIT_L(0); PG8_BAR; PG8_MMA(1, 0, At, B0); PG8_MMA(1, 1, At, B1); PG8_BAR; PG8_SCHED;
            PG8_LDB(B0, 1, 0); PG8_LDB(B1, 1, 1); PG8_SCHED; PG8_LDA(At, 1, 0); PG8_STAGE_A(0, 1, a2, gsel);
            PG8_WAIT_V(8); PG8_WAIT_L(0); PG8_BAR; PG8_MMA(0, 0, At, B0); PG8_MMA(0, 1, At, B1); PG8_BAR; PG8_SCHED;
            PG8_LDA(At, 1, 1); PG8_STAGE(PG8_SB(1, 0), b3, voffB); PG8_STAGE(PG8_SB(1, 1), b3 + hstep, voffB); PG8_STAGE_A(1, 0, a3, gsel);
            PG8_WAIT_V(8); PG8_WAIT_L(0); PG8_BAR; PG8_MMA(1, 0, At, B0); PG8_MMA(1, 1, At, B1); PG8_BAR; PG8_SCHED;
        }
        if (wr == 0) PG8_BAR;
        E(acc, cur, wr, wc, fr, fq);
        if (!has_next) break;
#pragma unroll
        for (int a = 0; a < 2; ++a)
#pragma unroll
            for (int b = 0; b < 2; ++b)
#pragma unroll
                for (int m = 0; m < 4; ++m)
#pragma unroll
                    for (int n = 0; n < 2; ++n) acc[a][b][m][n] = (f32x4){0.f, 0.f, 0.f, 0.f};
        cur = nxt; cA = nA; cB = nB; ++ui;
        if constexpr (GATHER) {
#pragma unroll
            for (int h = 0; h < 2; ++h)
#pragma unroll
                for (int i = 0; i < 2; ++i) gcur[h][i] = gnxt[h][i]; }
        if (wr == 1) PG8_BAR;
    }
    PG8_WAIT_V(0);
    PG8_BAR;
#undef PG8_SA
#undef PG8_SB
#undef PG8_STAGE
#undef PG8_STAGE_A
#undef PG8_GSET
#undef PG8_LDA
#undef PG8_LDB
#undef PG8_MMA
#undef PG8_WAIT_V
#undef PG8_WAIT_L
#undef PG8_BAR
#undef PG8_SCHED
}
}
#define MIXER_PHASES
constexpr int NWAVES = 8, NTHR = NWAVES * 64;
constexpr size_t MiB = 1u << 20;
constexpr size_t WS_CTL = 0, CTL_ZERO_BYTES = 1 * MiB;
constexpr size_t WS_MOD = 1 * MiB;
constexpr size_t WS_LB = WS_MOD + 512 * 1024;
constexpr size_t WS_LAM = WS_LB + 16 * 1024;
constexpr size_t WS_SEL = 2 * MiB;
constexpr size_t WS_SELPOS = WS_SEL + 64 * 1024, WS_ROWW = WS_SEL + 128 * 1024, WS_ROWTOK = WS_ROWW + 512 * 1024;
constexpr size_t WS_WIN = 4 * MiB;
constexpr size_t WS_WOUT = WS_WIN + (size_t)DEPTH * INC * D * 2;
constexpr size_t WS_WGU = WS_WOUT + (size_t)DEPTH * D * D * 2;
constexpr size_t WS_WD = WS_WGU + (size_t)DEPTH * NE * 1024 * D * 2;
constexpr size_t WS_X = WS_WD + (size_t)DEPTH * NE * D * DE * 2;
constexpr size_t WS_HB = WS_X + (size_t)T * D * 4;
constexpr size_t WS_P = WS_HB + (size_t)T * D * 2;
constexpr size_t WS_LF = WS_P + (size_t)T * INC * 2;
constexpr size_t WS_MIX = WS_LF + (size_t)T * 1024 * 4;
constexpr size_t WS_KV = WS_MIX + (size_t)T * D * 2;
constexpr size_t WS_DEC = WS_KV + (size_t)NB * 8 * NCH * 128 * 128 * 4;
constexpr size_t WS_ST = WS_DEC + (size_t)NB * 8 * NCH * 128 * 4;
constexpr size_t WS_ACT = WS_ST + (size_t)NB * 8 * NCH * 128 * 128 * 2;
constexpr size_t WS_Y1 = WS_ACT + (size_t)20480 * DE * 2;
constexpr size_t WS_HRAW = WS_Y1 + (size_t)T * D * 2;
constexpr size_t WS_END = WS_HRAW + (size_t)T * 1024 * 4;
constexpr int CW_TMO = 0;
constexpr int CW_CNT = 64;
constexpr int CW_BAR = 4096;

constexpr int RING_BYTES = 131072, LDSCTL_OFF = RING_BYTES, LDS_TB_OFF = LDSCTL_OFF + 64, MISC_OFF = LDSCTL_OFF + 320, LDS_BYTES = 147456;

#define RLX_AGENT __ATOMIC_RELAXED, __HIP_MEMORY_SCOPE_AGENT
#define LDS_WAIT() asm volatile("s_waitcnt lgkmcnt(0)" ::: "memory")
#define VM_WAIT() asm volatile("s_waitcnt vmcnt(0)" ::: "memory")

#define XB_TMO      128
#define XB_XCNT(j)  (256  + 64 * (j))
#define XB_XSUB(j)  (1280 + 64 * (j))
#define XB_XGEN(j)  (2304 + 64 * (j))
#define XB_TOP      3328
#define XB_TOPGEN   3392
#define XCD_BAR_WORDS 3456
#define XB_SPIN_CAP (1u << 22)
__device__ __forceinline__ unsigned xb_ld(unsigned* p)              { return __hip_atomic_load(p, __ATOMIC_RELAXED, __HIP_MEMORY_SCOPE_AGENT); }
__device__ __forceinline__ unsigned xb_add(unsigned* p, unsigned v) { return __hip_atomic_fetch_add(p, v, __ATOMIC_RELAXED, __HIP_MEMORY_SCOPE_AGENT); }
__device__ __forceinline__ unsigned xb_xcc_id() { return (unsigned)__builtin_amdgcn_s_getreg((3 << 11) | 20) & 0xFu; }
#define XB_SPIN(cond, bar) do { unsigned _sp = 0; while (cond) { __builtin_amdgcn_s_sleep(1); \
    if ((++_sp & 255u) == 0u) { if (xb_ld(&(bar)[XB_TMO])) break; if (_sp > XB_SPIN_CAP) { atomicAdd(&(bar)[XB_TMO], 1u); break; } } } } while (0)
struct XcdBarrier { unsigned* bar; unsigned x; volatile LAS unsigned* st; };
__device__ __forceinline__ XcdBarrier xcd_barrier_post(unsigned* bar, volatile LAS unsigned* st) {
    XcdBarrier b; b.bar = bar; b.x = xb_xcc_id(); b.st = st;
    if (threadIdx.x == 0) (void)xb_add(&bar[XB_XCNT(b.x)], 1u);
    return b;
}
__device__ __forceinline__ void xcd_barrier_complete(unsigned* bar, unsigned x, unsigned& nloc, unsigned& nx) {
    const unsigned G = gridDim.x * gridDim.y * gridDim.z;
    unsigned sum, cnt, mine, sp = 0u;
    for (;;) {
        sum = 0u; cnt = 0u; mine = 0u;
#pragma unroll
        for (unsigned j = 0; j < 16; ++j) { const unsigned c = xb_ld(&bar[XB_XCNT(j)]); sum += c; cnt += (c > 0u) ? 1u : 0u; mine = (j == x) ? c : mine; }
        if (sum == G) break;
        __builtin_amdgcn_s_sleep(1);
        if ((++sp & 255u) == 0u) { if (xb_ld(&bar[XB_TMO])) break; if (sp > XB_SPIN_CAP) { atomicAdd(&bar[XB_TMO], 1u); break; } }
    }
    nloc = mine > 0u ? mine : 1u; nx = cnt > 0u ? cnt : 1u;
}
__device__ __forceinline__ void xcd_barrier(const XcdBarrier& b) {
    asm volatile("s_waitcnt vmcnt(0)" ::: "memory");
    __syncthreads();
    if (threadIdx.x == 0) {
        unsigned* bar = b.bar;
        __builtin_amdgcn_s_waitcnt(0);
        unsigned nloc = b.st[0], nx = b.st[1];
        if (nloc == 0u) { xcd_barrier_complete(bar, b.x, nloc, nx); b.st[0] = nloc; b.st[1] = nx; }
        const unsigned old = xb_add(&bar[XB_XSUB(b.x)], 1u);
        const unsigned gen = old / nloc;
        if (old + 1u == (gen + 1u) * nloc) {
            __builtin_amdgcn_fence(__ATOMIC_RELEASE, "agent");
            asm volatile("s_waitcnt vmcnt(0)" ::: "memory");
            const unsigned og = xb_add(&bar[XB_TOP], 1u);
            const unsigned tg = og / nx;
            if (og + 1u == (tg + 1u) * nx) xb_add(&bar[XB_TOPGEN], 1u);
            else XB_SPIN(xb_ld(&bar[XB_TOPGEN]) == tg, bar);
            __builtin_amdgcn_fence(__ATOMIC_ACQUIRE, "agent");
            xb_add(&bar[XB_XGEN(b.x)], 1u);
            asm volatile("s_waitcnt vmcnt(0)" ::: "memory");
        } else {
            XB_SPIN(xb_ld(&bar[XB_XGEN(b.x)]) == gen, bar);
            __builtin_amdgcn_fence(__ATOMIC_ACQUIRE, "agent");
            asm volatile("s_waitcnt vmcnt(0)" ::: "memory");
        }
    }
    __syncthreads();
}

__device__ __forceinline__ void transpose_item(const float* W, int K, int N, bf16_t* WT, int k0, int n0, int drow0, LAS float* scr, int lane) {
#pragma unroll 8
    for (int i = 0; i < 32; ++i) { const int kk = 2 * i + (lane >> 5); scr[kk * 33 + (lane & 31)] = W[(size_t)(k0 + kk) * N + n0 + (lane & 31)]; }
    LDS_WAIT(); asm volatile("" ::: "memory");
    const int c = lane & 7;
#pragma unroll
    for (int j = 0; j < 4; ++j) { const int n = (lane >> 3) + 8 * j; const LAS float* s = scr + (8 * c) * 33 + n;
        u32x4 o; o.x = pk2(s[0 * 33], s[1 * 33]); o.y = pk2(s[2 * 33], s[3 * 33]); o.z = pk2(s[4 * 33], s[5 * 33]); o.w = pk2(s[6 * 33], s[7 * 33]);
        *(u32x4*)(WT + (size_t)(drow0 + n) * K + k0 + 8 * c) = o; }
    LDS_WAIT(); asm volatile("" ::: "memory");
}

struct Args { const float* in[22]; float* out; unsigned char* ws; int l_lo, l_hi, ph_lo, ph_hi, one, pad; };
enum { PH_PRO = 0, PH_NORM1 = 1, PH_PROJ = 2, PH_ATT = 3, PH_SCAN = 4, PH_HG3 = 5, PH_OUT = 6, PH_ROUTE = 7, PH_UP = 8, PH_DOWN = 9, PH_FINAL = 10 };

template <bool ROUTER>
__device__ __forceinline__ void norm_rows(const Args& args, unsigned char* ws, int l, int wg, int tid, int wave, int lane, LAS unsigned char* lds, bool addy, const float* gain, int shift_idx, int scale_idx) {
    float* Xp = (float*)(ws + WS_X); const bf16_t* Y1p = (const bf16_t*)(ws + WS_Y1); bf16_t* HBp = (bf16_t*)(ws + WS_HB);
    const float* modl = (const float*)(ws + WS_MOD) + (size_t)l * NB * MODW;
    const int row0 = wg * 32, b = row0 / S;
    const float* sh = modl + b * MODW + shift_idx * D; const float* sc = modl + b * MODW + scale_idx * D;
    LAS float* wr = (LAS float*)lds;
    if (ROUTER) {
        const float* w_router = args.in[16];
        for (int i = tid; i < D * NE / 4; i += NTHR) { const f32x4 v = *(const f32x4*)(w_router + 4 * i); const int j = i >> 2, e = (i & 3) * 4;
            wr[(e + 0) * D + j] = v[0]; wr[(e + 1) * D + j] = v[1]; wr[(e + 2) * D + j] = v[2]; wr[(e + 3) * D + j] = v[3]; }
        __syncthreads();
    }
    f32x4 ga[8], sv[8];
#pragma unroll
    for (int j = 0; j < 8; ++j) { const int c = 4 * lane + 256 * j; const f32x4 g = *(const f32x4*)(gain + c), s1 = *(const f32x4*)(sc + c); ga[j] = g * (s1 + 1.f); sv[j] = *(const f32x4*)(sh + c); }
    for (int i = 0; i < 4; ++i) {
        const int row = row0 + wave + 8 * i;
        float* xr = Xp + (size_t)row * D;
        f32x4 v[8]; float ss = 0.f;
#pragma unroll
        for (int j = 0; j < 8; ++j) { const int c = 4 * lane + 256 * j; v[j] = *(const f32x4*)(xr + c);
            if (addy) { const u32x2 y = *(const u32x2*)(Y1p + (size_t)row * D + c); v[j][0] += bflo(y.x); v[j][1] += bfhi(y.x); v[j][2] += bflo(y.y); v[j][3] += bfhi(y.y); *(f32x4*)(xr + c) = v[j]; }
            ss += (v[j][0] * v[j][0] + v[j][1] * v[j][1]) + (v[j][2] * v[j][2] + v[j][3] * v[j][3]); }
        const float r = rsqrtf(wave_sum(ss) * (1.f / D) + EPS);
#pragma unroll
        for (int j = 0; j < 8; ++j) { const int c = 4 * lane + 256 * j; v[j] = v[j] * r * ga[j] + sv[j];
            u32x2 o; o.x = pk2(v[j][0], v[j][1]); o.y = pk2(v[j][2], v[j][3]); *(u32x2*)(HBp + (size_t)row * D + c) = o; }
        if (ROUTER) {
            float mine = 0.f;
#pragma unroll 1
            for (int e = 0; e < NE; ++e) { float a = 0.f;
#pragma unroll
                for (int j = 0; j < 8; ++j) { const f32x4 w = *(const LAS f32x4*)(wr + e * D + 4 * lane + 256 * j); a += (v[j][0] * w[0] + v[j][1] * w[1]) + (v[j][2] * w[2] + v[j][3] * w[3]); }
                a = wave_sum(a); if (lane == e) mine = a; }
            float p[NE];
#pragma unroll
            for (int e = 0; e < NE; ++e) p[e] = __shfl(mine, e);
            if (lane == 0) {
                const float* b_router = args.in[17];
                float m = -1e30f;
#pragma unroll
                for (int e = 0; e < NE; ++e) { p[e] += b_router[e]; m = fmaxf(m, p[e]); }
                float s = 0.f;
#pragma unroll
                for (int e = 0; e < NE; ++e) { p[e] = expf(p[e] - m); s += p[e]; }
#pragma unroll
                for (int e = 0; e < NE; ++e) p[e] /= s;
                int gs = 0; float best = -1.f;
#pragma unroll
                for (int g = 0; g < 4; ++g) { float a = -1.f, c2 = -1.f;
#pragma unroll
                    for (int q = 0; q < 4; ++q) { const float pv = p[g * 4 + q]; if (pv > a) { c2 = a; a = pv; } else if (pv > c2) c2 = pv; }
                    if (a + c2 > best) { best = a + c2; gs = g; } }
                float q4[4];
#pragma unroll
                for (int q = 0; q < 4; ++q) q4[q] = gs == 0 ? p[q] : gs == 1 ? p[4 + q] : gs == 2 ? p[8 + q] : p[12 + q];
                int e0 = -1, e1 = -1; float v0 = -2.f, v1 = -2.f;
#pragma unroll
                for (int q = 0; q < 4; ++q) { const float pv = q4[q]; if (pv > v0) { v1 = v0; e1 = e0; v0 = pv; e0 = gs * 4 + q; } else if (pv > v1) { v1 = pv; e1 = gs * 4 + q; } }
                const float den = v0 + v1;
                unsigned* cnt = (unsigned*)(ws + WS_CTL) + CW_CNT + 64 * l;
                const int p0 = (int)atomicAdd(&cnt[e0], 1u), p1 = (int)atomicAdd(&cnt[e1], 1u);
                float* roww = (float*)(ws + WS_ROWW); int* rowtok = (int*)(ws + WS_ROWTOK);
                roww[e0 * T + p0] = v0 / den; roww[e1 * T + p1] = v1 / den; rowtok[e0 * T + p0] = row; rowtok[e1 * T + p1] = row | (int)0x80000000;
            }
        }
    }
}

__global__ void __launch_bounds__(NTHR, 2) mk_fwd(Args args) {
    extern __shared__ __attribute__((aligned(16))) unsigned char lds_raw[];
    LAS unsigned char* lds = (LAS unsigned char*)lds_raw;
    const int G = gridDim.x, wg = blockIdx.x;
    XcdBarrier bar;
    {
        const int tid = threadIdx.x; unsigned* ctl = (unsigned*)(args.ws + WS_CTL);
        volatile LAS unsigned* MISC = (volatile LAS unsigned*)(lds + MISC_OFF);
        for (int u = tid; u < (LDS_BYTES - LDSCTL_OFF) / 4; u += NTHR) ((LAS unsigned*)(lds + LDSCTL_OFF))[u] = 0u;
        __syncthreads();
        bar.bar = ctl + CW_BAR; bar.x = 0; bar.st = nullptr;
        if (args.one) bar = xcd_barrier_post(ctl + CW_BAR, MISC + 8);
    }
#define GRID_BAR() do { if (args.one) xcd_barrier(bar); } while (0)
#define IN(k) (args.ph_lo <= (k) && (k) < args.ph_hi)
#define X ((float*)(ws + WS_X))
#define HB ((bf16_t*)(ws + WS_HB))
#define P ((bf16_t*)(ws + WS_P))
#define LF ((float*)(ws + WS_LF))
#define MIX ((bf16_t*)(ws + WS_MIX))
#define ACT ((bf16_t*)(ws + WS_ACT))
#define Y1 ((bf16_t*)(ws + WS_Y1))
#define MOD ((float*)(ws + WS_MOD))
#define LB ((float*)(ws + WS_LB))
#define LAM ((float*)(ws + WS_LAM))
#define PHASE_LOCALS unsigned char* ws = args.ws; asm volatile("" : "+s"(ws)); int tid = threadIdx.x; asm volatile("" : "+v"(tid)); \
    const int lane = tid & 63, wave = __builtin_amdgcn_readfirstlane(tid >> 6); (void)lane; (void)wave; unsigned* ctl = (unsigned*)(ws + WS_CTL); (void)ctl;

#ifndef NO_PRO
    if (args.l_lo == 0 && IN(PH_PRO)) { PHASE_LOCALS
        if (wg == 0) {
            for (int j = tid; j < 1024; j += NTHR) { const float* hl = args.in[13]; float v[DEPTH], m = -1e30f;
                for (int l = 0; l < DEPTH; ++l) { v[l] = hl[l * 1024 + j]; m = fmaxf(m, v[l]); }
                float s = 0.f; for (int l = 0; l < DEPTH; ++l) { v[l] = expf(v[l] - m); s += v[l]; }
                float cum = 0.f; const float s0 = v[0] / s;
                for (int l = 0; l < DEPTH; ++l) { cum += v[l] / s; LB[l * 1024 + j] = fmaxf(cum - s0, 0.f); } }
            if (tid < DEPTH) { float a = 0.f, b = 0.f;
                for (int i = 0; i < 64; ++i) { a += args.in[8][tid * 64 + i] * args.in[9][tid * 64 + i]; b += args.in[10][tid * 64 + i] * args.in[11][tid * 64 + i]; }
                LAM[tid] = expf(a) - expf(b) + (0.8f - 0.6f * expf(-0.3f * (float)tid)); }
        }
        {
            LAS float* ca = (LAS float*)lds; LAS float* red = ca + NB * D;
            for (int i = tid; i < NB * D; i += NTHR) ca[i] = siluf_(args.in[1][i]);
            __syncthreads();
            for (int item = wg; item < DEPTH * 64; item += G) {
                const int l = item >> 6, c0 = (item & 63) * 192;
                if (tid < 384) { const int cg = tid % 48, ks = tid / 48; const float* w = args.in[6] + (size_t)l * D * MODW + c0 + 4 * cg;
                    f32x4 a0 = {0.f, 0.f, 0.f, 0.f}, a1 = a0;
#pragma unroll 8
                    for (int k = ks * 256; k < ks * 256 + 256; ++k) { const f32x4 wv = *(const f32x4*)(w + (size_t)k * MODW); a0 += wv * ca[k]; a1 += wv * ca[D + k]; }
#pragma unroll
                    for (int q = 0; q < 4; ++q) { red[(ks * 2 + 0) * 192 + 4 * cg + q] = a0[q]; red[(ks * 2 + 1) * 192 + 4 * cg + q] = a1[q]; } }
                __syncthreads();
                if (tid < 384) { const int b = tid / 192, c = tid % 192; float s = args.in[7][l * MODW + c0 + c];
                    for (int ks = 0; ks < 8; ++ks) s += red[(ks * 2 + b) * 192 + c];
                    MOD[(size_t)(l * NB + b) * MODW + c0 + c] = s; }
                __syncthreads();
            }
        }
        {
            LAS float* scr = (LAS float*)(lds + wave * 16384);
            const int gw = wg * NWAVES + wave, NGW = G * NWAVES;
            constexpr int I_IN = (D / 64) * (INC / 32), I_OUT = (D / 64) * (D / 32), I_G = (D / 64) * (DE / 32), I_D = (DE / 64) * (D / 32);
            constexpr int N_IN = DEPTH * I_IN, N_OUT = DEPTH * I_OUT, N_G = DEPTH * NE * I_G, N_D = DEPTH * NE * I_D;
            for (int it = gw; it < N_IN + N_OUT + 2 * N_G + N_D; it += NGW) {
                int r = it;
                if (r < N_IN) { const int l = r / I_IN, q = r % I_IN, nblk = INC / 32, kb = q / nblk, nb = q % nblk;
                    transpose_item(args.in[2] + (size_t)l * D * INC, D, INC, (bf16_t*)(ws + WS_WIN) + (size_t)l * INC * D, 64 * kb, 32 * nb, 32 * nb, scr, lane); continue; } r -= N_IN;
                if (r < N_OUT) { const int l = r / I_OUT, q = r % I_OUT, nblk = D / 32, kb = q / nblk, nb = q % nblk;
                    transpose_item(args.in[3] + (size_t)l * D * D, D, D, (bf16_t*)(ws + WS_WOUT) + (size_t)l * D * D, 64 * kb, 32 * nb, 32 * nb, scr, lane); continue; } r -= N_OUT;
                if (r < 2 * N_G) { const int up = r >= N_G; if (up) r -= N_G; const int le = r / I_G, q = r % I_G, nblk = DE / 32, kb = q / nblk, nb = q % nblk, n0 = 32 * nb;
                    transpose_item(args.in[up ? 19 : 18] + (size_t)le * D * DE, D, DE, (bf16_t*)(ws + WS_WGU) + (size_t)le * 1024 * D, 64 * kb, n0, (n0 >> 7) * 256 + (up ? 128 : 0) + (n0 & 127), scr, lane); continue; } r -= 2 * N_G;
                { const int le = r / I_D, q = r % I_D, nblk = D / 32, kb = q / nblk, nb = q % nblk;
                    transpose_item(args.in[20] + (size_t)le * DE * D, DE, D, (bf16_t*)(ws + WS_WD) + (size_t)le * D * DE, 64 * kb, 32 * nb, 32 * nb, scr, lane); }
            }
            for (size_t i = (size_t)(wg * NTHR + tid); i < (size_t)T * D / 4; i += (size_t)G * NTHR) ((f32x4*)X)[i] = ((const f32x4*)args.in[0])[i];
        }
        GRID_BAR();
    }
#endif

    for (int l = args.l_lo; l < args.l_hi; ++l) {
#ifndef NO_NORM1
        if (IN(PH_NORM1)) { PHASE_LOCALS norm_rows<false>(args, ws, l, wg, tid, wave, lane, lds, l > 0, args.in[4] + l * D, 0, 1); GRID_BAR(); }
#endif
#ifndef NO_PROJ
        if (IN(PH_PROJ)) { PHASE_LOCALS
            pg8::Gemm g{HB, (const bf16_t*)(ws + WS_WIN) + (size_t)l * INC * D, D}; pg8::StaticOrder So; So.init(T, INC, G, wg);
            pg8::EpiProj E{P, LF, LB + l * 1024};
            pg8::gemm_phase<pg8::EpiProj, pg8::StaticOrder, false>(lds, g, So, E);
            GRID_BAR();
        }
#endif
        MIXER_PHASES
#ifndef NO_OUT
        if (IN(PH_OUT)) { PHASE_LOCALS const float* modl = MOD + (size_t)l * NB * MODW;
            pg8::Gemm g{MIX, (const bf16_t*)(ws + WS_WOUT) + (size_t)l * D * D, D}; pg8::StaticOrder So; So.init(T, D, G, wg);
            pg8::EpiResid E{X, modl + 2 * D};
            pg8::gemm_phase<pg8::EpiResid, pg8::StaticOrder, false>(lds, g, So, E);
            GRID_BAR();
        }
#endif
#ifndef NO_ROUTE
        if (IN(PH_ROUTE)) { PHASE_LOCALS norm_rows<true>(args, ws, l, wg, tid, wave, lane, lds, false, args.in[5] + l * D, 3, 4); GRID_BAR(); }
#endif
        if (IN(PH_UP) || IN(PH_DOWN)) { PHASE_LOCALS const float* modl = MOD + (size_t)l * NB * MODW; unsigned* cnt = ctl + CW_CNT + 64 * l;
            LAS int* tb = (LAS int*)(lds + LDS_TB_OFF);
            if (tid == 0) { int a = 0; for (int e = 0; e < NE; ++e) { const int n = (int)__hip_atomic_load(&cnt[e], RLX_AGENT); tb[e] = a; tb[17 + e] = n; a += (n + 255) >> 8; } tb[16] = a; }
            __syncthreads();
#ifndef NO_UP
            if (IN(PH_UP)) {
                pg8::Gemm g{HB, (const bf16_t*)(ws + WS_WGU) + (size_t)l * NE * 1024 * D, D}; pg8::MoeOrder So{tb, (const int*)(ws + WS_ROWTOK), 4, G, wg};
                pg8::EpiMoeUp E{ACT, (const float*)(ws + WS_ROWW)};
                pg8::gemm_phase<pg8::EpiMoeUp, pg8::MoeOrder, true>(lds, g, So, E);
                GRID_BAR();
            }
#endif
#ifndef NO_DOWN
            if (IN(PH_DOWN)) {
                pg8::Gemm g{ACT, (const bf16_t*)(ws + WS_WD) + (size_t)l * NE * D * DE, DE}; pg8::MoeOrder So{tb, (const int*)(ws + WS_ROWTOK), 8, G, wg};
                pg8::EpiMoeDown E{X, Y1, modl + 5 * D, (const int*)(ws + WS_ROWTOK)};
                pg8::gemm_phase<pg8::EpiMoeDown, pg8::MoeOrder, false>(lds, g, So, E);
                GRID_BAR();
            }
#endif
        }
    }
    if (args.l_hi == DEPTH && IN(PH_FINAL)) { PHASE_LOCALS
        const int row0 = wg * 32; const float* gain = args.in[21];
        f32x4 ga[8];
#pragma unroll
        for (int j = 0; j < 8; ++j) ga[j] = *(const f32x4*)(gain + 4 * lane + 256 * j);
        for (int i = 0; i < 4; ++i) { const int row = row0 + wave + 8 * i; const float* xr = X + (size_t)row * D; f32x4 v[8]; float ss = 0.f;
#pragma unroll
            for (int j = 0; j < 8; ++j) { const int c = 4 * lane + 256 * j; v[j] = *(const f32x4*)(xr + c); const u32x2 y = *(const u32x2*)(Y1 + (size_t)row * D + c);
                v[j][0] += bflo(y.x); v[j][1] += bfhi(y.x); v[j][2] += bflo(y.y); v[j][3] += bfhi(y.y); ss += (v[j][0] * v[j][0] + v[j][1] * v[j][1]) + (v[j][2] * v[j][2] + v[j][3] * v[j][3]); }
            const float r = rsqrtf(wave_sum(ss) * (1.f / D) + EPS);
#pragma unroll
            for (int j = 0; j < 8; ++j) *(f32x4*)(args.out + (size_t)row * D + 4 * lane + 256 * j) = v[j] * r * ga[j]; }
    }
#undef GRID_BAR
#undef IN
#undef X
#undef HB
#undef P
#undef LF
#undef MIX
#undef ACT
#undef Y1
#undef MOD
#undef LB
#undef LAM
}
__global__ void __launch_bounds__(256) s_attn(const bf16_t* P, const float* rel_bias, const float* lam_p, const float* subln, int layer, bf16_t* MIX) {
    __shared__ float qv[128], s1[S], s2[S], red[8], ob[2][128];
    const int q = blockIdx.x, h = blockIdx.y, b = blockIdx.z, tid = threadIdx.x;
    const size_t rowq = (size_t)(b * S + q) * INC;
    if (tid < 128) qv[tid] = bf2f(P[rowq + C_QD + h * 128 + tid]);
    __syncthreads();
    const int nk = q + 1;
    float m1 = -1e30f, m2 = -1e30f;
    for (int k = tid; k < nk; k += 256) {
        const bf16_t* kr = P + (size_t)(b * S + k) * INC + C_KD + h * 128;
        float d1 = 0.f, d2 = 0.f;
        for (int i = 0; i < 64; ++i) { d1 += qv[i] * bf2f(kr[i]); d2 += qv[64 + i] * bf2f(kr[64 + i]); }
        const int n = q - k; const int bk = n < 128 ? (int)T5B[n] : 31;
        d1 += rel_bias[bk * 16 + 2 * h] * LOG2E; d2 += rel_bias[bk * 16 + 2 * h + 1] * LOG2E;
        s1[k] = d1; s2[k] = d2; m1 = fmaxf(m1, d1); m2 = fmaxf(m2, d2);
    }
    m1 = block_max256(m1, red); m2 = block_max256(m2, red);
    float l1 = 0.f, l2 = 0.f;
    for (int k = tid; k < nk; k += 256) { const float e1 = exp2f(s1[k] - m1), e2 = exp2f(s2[k] - m2); s1[k] = e1; s2[k] = e2; l1 += e1; l2 += e2; }
    l1 = block_sum256(l1, red); l2 = block_sum256(l2, red);
    const float lam = lam_p[layer]; const float i1 = 1.f / l1, i2 = lam / l2;
    const int d = tid & 127, half = tid >> 7;
    float acc = 0.f;
    for (int k = half; k < nk; k += 2) acc += (s1[k] * i1 - s2[k] * i2) * bf2f(P[(size_t)(b * S + k) * INC + C_VD + h * 128 + d]);
    ob[half][d] = acc;
    __syncthreads();
    float o = 0.f;
    if (tid < 128) o = ob[0][tid] + ob[1][tid];
    const float ss = block_sum256(tid < 128 ? o * o : 0.f, red);
    const float lambda_init = 0.8f - 0.6f * expf(-0.3f * (float)layer);
    if (tid < 128) MIX[(size_t)(b * S + q) * D + h * 128 + tid] = (bf16_t)f2bf(o * rsqrtf(ss / 128.f + EPS) * subln[layer * 128 + tid] * (1.f - lambda_init));
}
__global__ void __launch_bounds__(128) s_hgrn(const bf16_t* P, const float* LF, float* hraw) {
    __shared__ float red[2][2][8];
    const int js = blockIdx.x, h = blockIdx.y, b = blockIdx.z, d = threadIdx.x, w = d >> 6;
    float St[8];
    for (int i = 0; i < 8; ++i) St[i] = 0.f;
    for (int t = 0; t < S; ++t) {
        const size_t row = (size_t)(b * S + t);
        const bf16_t* pr = P + row * INC;
        const float f = expf(LF[row * 1024 + h * 128 + d]), kk = bf2f(pr[C_FH + h * 128 + d]), qq = bf2f(pr[C_QH + h * 128 + d]);
        float part[8];
        for (int i = 0; i < 8; ++i) { const float vv = bf2f(pr[C_IH + h * 128 + js * 8 + i]); St[i] = f * St[i] + kk * vv; part[i] = wave_sum(qq * St[i]); }
        if ((d & 63) == 0) for (int i = 0; i < 8; ++i) red[t & 1][w][i] = part[i];
        __syncthreads();
        if (d < 8) hraw[row * 1024 + h * 128 + js * 8 + d] = red[t & 1][0][d] + red[t & 1][1][d];
    }
}
__global__ void __launch_bounds__(256) s_hgrn_post(const float* hraw, const bf16_t* P, const float* hnorm_l, bf16_t* MIX) {
    const int t = blockIdx.x, tid = threadIdx.x;
    float v[4]; float ss = 0.f;
    for (int i = 0; i < 4; ++i) { v[i] = hraw[(size_t)t * 1024 + tid * 4 + i]; ss += v[i] * v[i]; }
    for (int o = 1; o < 32; o <<= 1) ss += __shfl_xor(ss, o);
    const float r = rsqrtf(ss / 128.f + EPS);
    for (int i = 0; i < 4; ++i) { const int j = tid * 4 + i; const float sg = bf2f(P[(size_t)t * INC + C_GH + j]); MIX[(size_t)t * D + 1024 + j] = (bf16_t)f2bf(v[i] * r * hnorm_l[j & 127] * sg); }
}
extern "C" void kernel_launch(void* const* d_in, const int* in_sizes, int n_in, void* d_out, int out_size, void* d_ws, size_t ws_size, hipStream_t stream) {
    static int grid = 0;
    if (grid == 0) {
        if (n_in != 22 || in_sizes[0] != T * D || out_size != T * D || ws_size < WS_END) { fprintf(stderr, "kernel_launch: unexpected shapes / workspace (%d inputs, ws %zu, need %zu)\n", n_in, ws_size, (size_t)WS_END); grid = -1; return; }
        int dev = 0, cus = 0;
        if (hipGetDevice(&dev) != hipSuccess || hipDeviceGetAttribute(&cus, hipDeviceAttributeMultiprocessorCount, dev) != hipSuccess) { grid = -1; return; }
        if (hipFuncSetAttribute((const void*)mk_fwd, hipFuncAttributeMaxDynamicSharedMemorySize, LDS_BYTES) != hipSuccess) { fprintf(stderr, "kernel_launch: hipFuncSetAttribute failed\n"); grid = -1; return; }
        int per_cu = 0;
        if (hipOccupancyMaxActiveBlocksPerMultiprocessor(&per_cu, (const void*)mk_fwd, NTHR, LDS_BYTES) != hipSuccess || per_cu < 1) fprintf(stderr, "kernel_launch: occupancy query reports %d\n", per_cu);
        (void)hipGetLastError();
        grid = cus < 256 ? cus : 256;
        if (grid != 256) fprintf(stderr, "kernel_launch: %d CUs; this kernel is laid out for 256\n", cus);
    }
    if (grid < 0) return;
    (void)hipMemsetAsync((char*)d_ws + WS_CTL, 0, CTL_ZERO_BYTES, stream);
    Args a{};
    for (int i = 0; i < 22; ++i) a.in[i] = (const float*)d_in[i];
    a.out = (float*)d_out; a.ws = (unsigned char*)d_ws;
    unsigned char* ws = (unsigned char*)d_ws;
    auto mk = [&](int l_lo, int l_hi, int ph_lo, int ph_hi, int one) {
        a.l_lo = l_lo; a.l_hi = l_hi; a.ph_lo = ph_lo; a.ph_hi = ph_hi; a.one = one; a.pad = 0;
        hipLaunchKernelGGL(mk_fwd, dim3(grid), dim3(NTHR), LDS_BYTES, stream, a);
    };
#if MK_ONE
    mk(0, DEPTH, 0, 11, 1);
#else
    mk(0, 0, PH_PRO, PH_PRO + 1, 0);
    for (int l = 0; l < DEPTH; ++l) {
        mk(l, l + 1, PH_NORM1, PH_NORM1 + 1, 0);
        mk(l, l + 1, PH_PROJ, PH_PROJ + 1, 0);
        s_attn<<<dim3(S, 8, NB), 256, 0, stream>>>((const bf16_t*)(ws + WS_P), (const float*)d_in[15], (const float*)(ws + WS_LAM), (const float*)d_in[12], l, (bf16_t*)(ws + WS_MIX));
        s_hgrn<<<dim3(16, 8, NB), 128, 0, stream>>>((const bf16_t*)(ws + WS_P), (const float*)(ws + WS_LF), (float*)(ws + WS_HRAW));
        s_hgrn_post<<<T, 256, 0, stream>>>((const float*)(ws + WS_HRAW), (const bf16_t*)(ws + WS_P), (const float*)d_in[14] + l * 128, (bf16_t*)(ws + WS_MIX));
        mk(l, l + 1, PH_OUT, PH_OUT + 1, 0);
        mk(l, l + 1, PH_ROUTE, PH_ROUTE + 1, 0);
        mk(l, l + 1, PH_UP, PH_UP + 1, 0);
        mk(l, l + 1, PH_DOWN, PH_DOWN + 1, 0);
    }
    mk(DEPTH, DEPTH, PH_FINAL, PH_FINAL + 1, 0);
#endif
}
```

```cpp
#include <hip/hip_runtime.h>
#include <cstdio>
#include <cstdint>
#include <cmath>

constexpr int NB = 2, S = 4096, D = 2048, T = NB * S, DEPTH = 4;
constexpr int INC = 7168, NMOD = 6, MODW = NMOD * D;
constexpr int NE = 16, DE = 512;
constexpr float EPS = 1e-6f;
constexpr int C_QD = 0, C_KD = 1024, C_VD = 2048, C_QH = 3072, C_FH = 4096, C_IH = 5120, C_GH = 6144;
constexpr float LOG2E = 1.4426950408889634f;
constexpr float QSCALE = 0.125f * LOG2E;
constexpr int NCH = S / 64;

typedef unsigned short bf16_t;
typedef short bf16x8 __attribute__((ext_vector_type(8)));
typedef float f32x4 __attribute__((ext_vector_type(4)));
typedef float f32x16 __attribute__((ext_vector_type(16)));
typedef unsigned u32x4 __attribute__((ext_vector_type(4)));
typedef unsigned u32x2 __attribute__((ext_vector_type(2)));
#define GAS __attribute__((address_space(1)))
#define LAS __attribute__((address_space(3)))

__device__ const unsigned char T5B[128] = {0, 1, 2, 3, 4, 5, 6, 7, 8, 9, 10, 11, 12, 13, 14, 15, 16, 16, 16, 17, 17, 18, 18, 18, 19, 19, 19, 20, 20, 20, 20, 21, 21, 21, 21, 22, 22, 22, 22, 22, 23, 23, 23, 23, 23, 23, 24, 24, 24, 24, 24, 24, 25, 25, 25, 25, 25, 25, 25, 26, 26, 26, 26, 26, 26, 26, 26, 27, 27, 27, 27, 27, 27, 27, 27, 27, 27, 28, 28, 28, 28, 28, 28, 28, 28, 28, 28, 29, 29, 29, 29, 29, 29, 29, 29, 29, 29, 29, 29, 30, 30, 30, 30, 30, 30, 30, 30, 30, 30, 30, 30, 30, 30, 31, 31, 31, 31, 31, 31, 31, 31, 31, 31, 31, 31, 31, 31, 31};

__device__ __forceinline__ float wave_sum(float v) {
#pragma unroll
    for (int o = 1; o < 64; o <<= 1) v += __shfl_xor(v, o);
    return v;
}
__device__ __forceinline__ float wave_max(float v) {
#pragma unroll
    for (int o = 1; o < 64; o <<= 1) v = fmaxf(v, __shfl_xor(v, o));
    return v;
}
__device__ __forceinline__ float block_sum256(float v, float* red) {
    v = wave_sum(v);
    __syncthreads();
    if ((threadIdx.x & 63) == 0) red[threadIdx.x >> 6] = v;
    __syncthreads();
    return red[0] + red[1] + red[2] + red[3];
}
__device__ __forceinline__ float block_max256(float v, float* red) {
    v = wave_max(v);
    __syncthreads();
    if ((threadIdx.x & 63) == 0) red[threadIdx.x >> 6] = v;
    __syncthreads();
    return fmaxf(fmaxf(red[0], red[1]), fmaxf(red[2], red[3]));
}
__device__ __forceinline__ float sigmoidf_(float x) { return 1.f / (1.f + expf(-x)); }
__device__ __forceinline__ float siluf_(float x) { return x / (1.f + expf(-x)); }
__device__ __forceinline__ unsigned f2bf(float f) { unsigned u = __builtin_bit_cast(unsigned, f); return (u + 0x7fffu + ((u >> 16) & 1u)) >> 16; }
__device__ __forceinline__ unsigned pk2(float lo, float hi) { return f2bf(lo) | (f2bf(hi) << 16); }
__device__ __forceinline__ float bf2f(unsigned short h) { return __builtin_bit_cast(float, (unsigned)h << 16); }
__device__ __forceinline__ float bflo(unsigned w) { return __builtin_bit_cast(float, w << 16); }
__device__ __forceinline__ float bfhi(unsigned w) { return __builtin_bit_cast(float, w & 0xffff0000u); }

__device__ __forceinline__ void hgrn_gate(float fr, float lbv, float& logf, float& kk) {
    const float s1 = 1.f / (1.f + expf(-fr)), s2 = 1.f / (1.f + expf(fr));
    const float f = lbv + (1.f - lbv) * s1;
    logf = __logf(fmaxf(f, 1.17549435e-38f)); kk = (1.f - lbv) * s2;
}
#ifndef MK_ONE
#define MK_ONE 0
#endif
namespace pg8 {
constexpr int BM = 256, BK = 64, HALF = 128, HTB = HALF * BK * 2  , STAGE_BYTES = 8 * HTB, NXCD = 8, WGM = 8;
__host__ __device__ __forceinline__ int lds_byte(int r, int c) { const int st = (r >> 4) * 2 + (c >> 5), rr = r & 15, cc = c & 31, ob = rr * 64 + cc * 2; return st * 1024 + (ob ^ (((ob >> 9) & 1) << 5)); }
__host__ __device__ __forceinline__ void stage_rc(int b, int& R, int& C) { const int st = b / 1024, sb = b % 1024, swz = sb ^ (((sb >> 9) & 1) << 5); R = (st >> 1) * 16 + swz / 64; C = (st & 1) * 32 + (swz % 64) / 2; }
__host__ __device__ __forceinline__ int perm32(int rho) { const int n = rho >> 4, i = rho & 15; return 8 * (i >> 2) + 4 * n + (i & 3); }

struct Unit { int pm, pn, e, ct, r0, n; };
struct Gemm { const bf16_t* A; const bf16_t* Bt; int K; };

struct StaticOrder {
    int nM, nN, nwg, G, c;
    __device__ void init(int M, int N, int G_, int c_) { nM = M / BM; nN = N / BM; nwg = nM * nN; G = G_; c = c_; }
    __device__ bool next(int i, Unit& u) const {
        const long L = (long)i * G + c; if (L >= nwg) return false;
        int wgid = (int)L; { const int q = nwg / NXCD, r = nwg % NXCD, xcd = wgid % NXCD, off = wgid / NXCD; wgid = (xcd < r ? xcd * (q + 1) : r * (q + 1) + (xcd - r) * q) + off; }
        const int nig = WGM * nN, gid = wgid / nig, fm = gid * WGM, gsz = (nM - fm) < WGM ? (nM - fm) : WGM;
        u.pm = fm + ((wgid % nig) % gsz); u.pn = (wgid % nig) / gsz; u.e = 0; u.ct = u.pn; u.r0 = 0; u.n = 0; return true;
    }
    __device__ __forceinline__ int arow(const Unit&, int) const { return 0; }
};
struct MoeOrder {
    const LAS int* tb; const int* rowtok; int ncol, G, c;
    __device__ bool next(int i, Unit& u) const {
        const int L = i * G + c; if (L >= tb[16] * ncol) return false;
        const int rt = L / ncol, ct = L - rt * ncol; int e = 0;
        while (tb[e + 1] <= rt) ++e;
        u.e = e; u.ct = ct; u.pm = rt; u.pn = e * ncol + ct; u.r0 = (rt - tb[e]) * 256; u.n = tb[17 + e]; return true;
    }
    __device__ __forceinline__ int arow(const Unit& u, int r) const { const int lr = u.r0 + r; return lr < u.n ? (rowtok[u.e * T + lr] & 0x7fffffff) : 0; }
};

__device__ __forceinline__ unsigned cvt_pk_bf16(float lo, float hi) { unsigned r; asm volatile("v_cvt_pk_bf16_f32 %0, %1, %2" : "=v"(r) : "v"(lo), "v"(hi)); return r; }

struct EpiProj {
    static constexpr bool PERM = true;
    bf16_t* P; float* LF; const float* lb;
    __device__ __forceinline__ void operator()(const f32x4 (&acc)[2][2][4][2], const Unit& u, int wr, int wc, int fr, int fq) const {
        const int row0 = u.pm * BM + wr * 64 + fr, colt = u.pn * BM, type = colt >> 10, col0 = colt + wc * 32 + 8 * fq;
#pragma unroll
        for (int ai = 0; ai < 2; ++ai)
#pragma unroll
            for (int m = 0; m < 4; ++m) { const int row = row0 + ai * HALF + m * 16; bf16_t* rowp = P + (size_t)row * INC + col0;
#pragma unroll
                for (int bj = 0; bj < 2; ++bj) { f32x4 v0 = acc[ai][bj][m][0], v1 = acc[ai][bj][m][1];
                    if (type == 0) { v0 = v0 * QSCALE; v1 = v1 * QSCALE; }
                    else if (type == 4) { const int ci = col0 + bj * HALF - C_FH; const f32x4 l0 = *(const f32x4*)(lb + ci), l1 = *(const f32x4*)(lb + ci + 4); f32x4 g0, g1;
#pragma unroll
                        for (int j = 0; j < 4; ++j) { float lf, kk; hgrn_gate(v0[j], l0[j], lf, kk); g0[j] = lf; v0[j] = kk; hgrn_gate(v1[j], l1[j], lf, kk); g1[j] = lf; v1[j] = kk; }
                        float* lfp = LF + (size_t)row * 1024 + ci; *(f32x4*)lfp = g0; *(f32x4*)(lfp + 4) = g1; }
                    else if (type == 6) {
#pragma unroll
                        for (int j = 0; j < 4; ++j) { v0[j] = siluf_(v0[j]); v1[j] = siluf_(v1[j]); } }
                    u32x4 w; w.x = cvt_pk_bf16(v0[0], v0[1]); w.y = cvt_pk_bf16(v0[2], v0[3]); w.z = cvt_pk_bf16(v1[0], v1[1]); w.w = cvt_pk_bf16(v1[2], v1[3]);
                    *(u32x4*)(rowp + bj * HALF) = w; } }
    }
};
struct EpiResid {
    static constexpr bool PERM = false;
    float* X; const float* gate;
    __device__ __forceinline__ void operator()(const f32x4 (&acc)[2][2][4][2], const Unit& u, int wr, int wc, int fr, int fq) const {
        const int row0 = u.pm * BM + wr * 64 + fr, col0 = u.pn * BM + wc * 32 + 4 * fq; const int b = (u.pm * BM) / S;
        f32x4 gv[2][2];
#pragma unroll
        for (int bj = 0; bj < 2; ++bj)
#pragma unroll
            for (int n = 0; n < 2; ++n) gv[bj][n] = *(const f32x4*)(gate + b * MODW + col0 + bj * HALF + n * 16);
#pragma unroll
        for (int ai = 0; ai < 2; ++ai)
#pragma unroll
            for (int m = 0; m < 4; ++m) { float* rowp = X + (size_t)(row0 + ai * HALF + m * 16) * D + col0;
#pragma unroll
                for (int bj = 0; bj < 2; ++bj)
#pragma unroll
                    for (int n = 0; n < 2; ++n) { f32x4* p = (f32x4*)(rowp + bj * HALF + n * 16); *p = *p + gv[bj][n] * acc[ai][bj][m][n]; } }
    }
};
struct EpiMoeUp {
    static constexpr bool PERM = true;
    bf16_t* act; const float* roww;
    __device__ __forceinline__ void operator()(const f32x4 (&acc)[2][2][4][2], const Unit& u, int wr, int wc, int fr, int fq) const {
        const int col0 = u.ct * 128 + wc * 32 + 8 * fq;
#pragma unroll
        for (int ai = 0; ai < 2; ++ai)
#pragma unroll
            for (int m = 0; m < 4; ++m) { const int r = ai * HALF + wr * 64 + m * 16 + fr, lr = u.r0 + r;
                if (lr < u.n) { const float w = roww[u.e * T + lr]; const f32x4 g0 = acc[ai][0][m][0], g1 = acc[ai][0][m][1], u0 = acc[ai][1][m][0], u1 = acc[ai][1][m][1]; f32x4 a0, a1;
#pragma unroll
                    for (int j = 0; j < 4; ++j) { a0[j] = siluf_(g0[j]) * u0[j] * w; a1[j] = siluf_(g1[j]) * u1[j] * w; }
                    u32x4 o; o.x = cvt_pk_bf16(a0[0], a0[1]); o.y = cvt_pk_bf16(a0[2], a0[3]); o.z = cvt_pk_bf16(a1[0], a1[1]); o.w = cvt_pk_bf16(a1[2], a1[3]);
                    *(u32x4*)(act + (size_t)(u.pm * BM + r) * DE + col0) = o; } }
    }
};
struct EpiMoeDown {
    static constexpr bool PERM = false;
    float* X; bf16_t* Y1; const float* gate; const int* rowtok;
    __device__ __forceinline__ void operator()(const f32x4 (&acc)[2][2][4][2], const Unit& u, int wr, int wc, int fr, int fq) const {
        const int col0 = u.ct * BM + wc * 32 + 4 * fq;
#pragma unroll
        for (int ai = 0; ai < 2; ++ai)
#pragma unroll
            for (int m = 0; m < 4; ++m) { const int lr = u.r0 + ai * HALF + wr * 64 + m * 16 + fr;
                if (lr < u.n) { const int ts = rowtok[u.e * T + lr], tok = ts & 0x7fffffff; const float* gp = gate + (tok / S) * MODW + col0;
                    if (ts >= 0) { float* rowp = X + (size_t)tok * D + col0;
#pragma unroll
                        for (int bj = 0; bj < 2; ++bj)
#pragma unroll
                            for (int n = 0; n < 2; ++n) { f32x4* p = (f32x4*)(rowp + bj * HALF + n * 16); *p = *p + *(const f32x4*)(gp + bj * HALF + n * 16) * acc[ai][bj][m][n]; } }
                    else { bf16_t* rowp = Y1 + (size_t)tok * D + col0;
#pragma unroll
                        for (int bj = 0; bj < 2; ++bj)
#pragma unroll
                            for (int n = 0; n < 2; ++n) { const f32x4 v = *(const f32x4*)(gp + bj * HALF + n * 16) * acc[ai][bj][m][n]; u32x2 o; o.x = cvt_pk_bf16(v[0], v[1]); o.y = cvt_pk_bf16(v[2], v[3]);
                                *(u32x2*)(rowp + bj * HALF + n * 16) = o; } } } }
    }
};

template <class Epi, class Sched, bool GATHER = false>
__device__ __forceinline__ void gemm_phase(LAS unsigned char* lds, const Gemm g, const Sched& S, const Epi& E) {
    int tid_ = threadIdx.x; asm volatile("" : "+v"(tid_));
    const int tid = tid_, wid = __builtin_amdgcn_readfirstlane(tid >> 6), lane = tid & 63, wr = wid >> 2, wc = wid & 3, fr = lane & 15, fq = lane >> 4;
    const int K = g.K, nt = K / BK;
    unsigned voffA[2], voffB[2]; int RA[2], CA[2];
#pragma unroll
    for (int i = 0; i < 2; ++i) { int R, C; stage_rc(tid * 16 + i * 8192, R, C); const int Rb = Epi::PERM ? ((R & ~31) + perm32(R & 31)) : R;
        voffA[i] = (unsigned)(R * K + C) * 2u; voffB[i] = (unsigned)(Rb * K + C) * 2u; RA[i] = R; CA[i] = C; }
    const size_t kstep = (size_t)(BK * 2);
    const size_t hstep = (size_t)HALF * K * 2;
    const size_t tstep = 2 * hstep;
    const unsigned ldsw = (unsigned)wid * 1024u;
    const int aoff = lds_byte(wr * 64 + fr, fq * 8), boff = lds_byte(wc * 32 + fr, fq * 8);
#define PG8_SA(b, h) (((b) * 2 + (h)) * HTB)
#define PG8_SB(b, h) ((4 + (b) * 2 + (h)) * HTB)
#define PG8_STAGE(bufoff, gbase, voff) do { _Pragma("unroll") for (int _i = 0; _i < 2; ++_i) \
        __builtin_amdgcn_global_load_lds((const unsigned*)((const char*)(gbase) + (voff)[_i]), (LAS unsigned*)(lds + (bufoff) + ldsw + _i * 8192), 16, 0, 0); } while (0)
#define PG8_STAGE_A(b, h, base, GO) do { if constexpr (GATHER) { PG8_STAGE(PG8_SA(b, h), base, GO[h]); } else { PG8_STAGE(PG8_SA(b, h), (base) + (h) * hstep, voffA); } } while (0)
#define PG8_GSET(GO, U) do { if constexpr (GATHER) { _Pragma("unroll") for (int _h = 0; _h < 2; ++_h) _Pragma("unroll") for (int _i = 0; _i < 2; ++_i) \
        GO[_h][_i] = (unsigned)(S.arow(U, _h * HALF + RA[_i]) * K + CA[_i]) * 2u; } } while (0)
#define PG8_LDA(dst, b, h) do { _Pragma("unroll") for (int m = 0; m < 4; ++m) _Pragma("unroll") for (int k = 0; k < 2; ++k) dst[m][k] = *(const LAS bf16x8*)(lds + PG8_SA(b, h) + aoff + m * 2048 + k * 1024); } while (0)
#define PG8_LDB(dst, b, h) do { _Pragma("unroll") for (int n = 0; n < 2; ++n) _Pragma("unroll") for (int k = 0; k < 2; ++k) dst[n][k] = *(const LAS bf16x8*)(lds + PG8_SB(b, h) + boff + n * 2048 + k * 1024); } while (0)
#define PG8_MMA(ai, bj, At, Bt) do { __builtin_amdgcn_s_setprio(1); _Pragma("unroll") for (int m = 0; m < 4; ++m) _Pragma("unroll") for (int n = 0; n < 2; ++n) _Pragma("unroll") for (int k = 0; k < 2; ++k) \
        acc[ai][bj][m][n] = __builtin_amdgcn_mfma_f32_16x16x32_bf16(Bt[n][k], At[m][k], acc[ai][bj][m][n], 0, 0, 0); __builtin_amdgcn_s_setprio(0); } while (0)
#define PG8_WAIT_V(n) asm volatile("s_waitcnt vmcnt(" #n ")" ::: "memory")
#define PG8_WAIT_L(n) asm volatile("s_waitcnt lgkmcnt(" #n ")" ::: "memory")
#define PG8_BAR __builtin_amdgcn_s_barrier()
#define PG8_SCHED __builtin_amdgcn_sched_barrier(0)
    Unit cur, nxt; int ui = 0;
    if (!S.next(0, cur)) return;
    f32x4 acc[2][2][4][2];
#pragma unroll
    for (int a = 0; a < 2; ++a)
#pragma unroll
        for (int b = 0; b < 2; ++b)
#pragma unroll
            for (int m = 0; m < 4; ++m)
#pragma unroll
                for (int n = 0; n < 2; ++n) acc[a][b][m][n] = (f32x4){0.f, 0.f, 0.f, 0.f};
    bf16x8 At[4][2], B0[2][2], B1[2][2];
    unsigned gcur[2][2] = {{0u, 0u}, {0u, 0u}}, gnxt[2][2] = {{0u, 0u}, {0u, 0u}}, gsel[2][2] = {{0u, 0u}, {0u, 0u}};
    const char* cA = GATHER ? (const char*)g.A : (const char*)g.A + (size_t)cur.pm * tstep; const char* cB = (const char*)g.Bt + (size_t)cur.pn * tstep;
    PG8_GSET(gcur, cur);
    PG8_STAGE(PG8_SB(0, 0), cB, voffB); PG8_STAGE(PG8_SB(0, 1), cB + hstep, voffB); PG8_STAGE_A(0, 0, cA, gcur); PG8_STAGE_A(0, 1, cA, gcur);
    if (wr == 1) PG8_BAR;
    PG8_WAIT_V(2); PG8_BAR;
    PG8_STAGE(PG8_SB(1, 0), cB + kstep, voffB); PG8_STAGE_A(1, 0, cA + kstep, gcur); PG8_STAGE(PG8_SB(1, 1), cB + hstep + kstep, voffB);
    PG8_WAIT_V(6); PG8_BAR;
    for (;;) {
        const bool has_next = S.next(ui + 1, nxt);
        const char* nA = GATHER ? (const char*)g.A : (has_next ? (const char*)g.A + (size_t)nxt.pm * tstep : cA); const char* nB = has_next ? (const char*)g.Bt + (size_t)nxt.pn * tstep : cB;
        if constexpr (GATHER) { if (has_next) { PG8_GSET(gnxt, nxt); } else {
#pragma unroll
            for (int h = 0; h < 2; ++h)
#pragma unroll
                for (int i = 0; i < 2; ++i) gnxt[h][i] = gcur[h][i]; } }
        for (int t = 0; t < nt; t += 2) {
            const bool last = (t == nt - 2);
            const char* a1 = cA + (size_t)(t + 1) * kstep;
            const char* a2 = last ? nA : cA + (size_t)(t + 2) * kstep; const char* b2 = last ? nB : cB + (size_t)(t + 2) * kstep;
            const char* a3 = a2 + kstep; const char* b3 = b2 + kstep;
            if constexpr (GATHER) {
#pragma unroll
                for (int h = 0; h < 2; ++h)
#pragma unroll
                    for (int i = 0; i < 2; ++i) gsel[h][i] = last ? gnxt[h][i] : gcur[h][i]; }
            PG8_LDB(B0, 0, 0); PG8_LDB(B1, 0, 1); PG8_SCHED; PG8_LDA(At, 0, 0); PG8_STAGE_A(1, 1, a1, gcur);
            PG8_WAIT_V(8); PG8_WAIT_L(0); PG8_BAR; PG8_MMA(0, 0, At, B0); PG8_MMA(0, 1, At, B1); PG8_BAR; PG8_SCHED;
            PG8_LDA(At, 0, 1); PG8_STAGE(PG8_SB(0, 0), b2, voffB); PG8_STAGE(PG8_SB(0, 1), b2 + hstep, voffB); PG8_STAGE_A(0, 0, a2, gsel);
            PG8_WAIT_V(8); PG8_WAIT_L(0); PG8_BAR; PG8_MMA(1, 0, At, B0); PG8_MMA(1, 1, At, B1); PG8_BAR; PG8_SCHED;
            PG8_LDB(B0, 1, 0); PG8_LDB(B1, 1, 1); PG8_SCHED; PG8_LDA(At, 1, 0); PG8_STAGE_A(0, 1, a2, gsel);
            PG8_WAIT_V(8); PG8_WAIT_L(0); PG8_BAR; PG8_MMA(0, 0, At, B0); PG8_MMA(0, 1, At, B1); PG8_BAR; PG8_SCHED;
            PG8_LDA(At, 1, 1); PG8_STAGE(PG8_SB(1, 0), b3, voffB); PG8_STAGE(PG8_SB(1, 1), b3 + hstep, voffB); PG8_STAGE_A(1, 0, a3, gsel);
            PG8_WAIT_V(8); PG8_WAIT_L(0); PG8_BAR; PG8_MMA(1, 0, At, B0); PG8_MMA(1, 1, At, B1); PG8_BAR; PG8_SCHED;
        }
        if (wr == 0) PG8_BAR;
        E(acc, cur, wr, wc, fr, fq);
        if (!has_next) break;
#pragma unroll
        for (int a = 0; a < 2; ++a)
#pragma unroll
            for (int b = 0; b < 2; ++b)
#pragma unroll
                for (int m = 0; m < 4; ++m)
#pragma unroll
                    for (int n = 0; n < 2; ++n) acc[a][b][m][n] = (f32x4){0.f, 0.f, 0.f, 0.f};
        cur = nxt; cA = nA; cB = nB; ++ui;
        if constexpr (GATHER) {
#pragma unroll
            for (int h = 0; h < 2; ++h)
#pragma unroll
                for (int i = 0; i < 2; ++i) gcur[h][i] = gnxt[h][i]; }
        if (wr == 1) PG8_BAR;
    }
    PG8_WAIT_V(0);
    PG8_BAR;
#undef PG8_SA
#undef PG8_SB
#undef PG8_STAGE
#undef PG8_STAGE_A
#undef PG8_GSET
#undef PG8_LDA
#undef PG8_LDB
#undef PG8_MMA
#undef PG8_WAIT_V
#undef PG8_WAIT_L
#undef PG8_BAR
#undef PG8_SCHED
}
}
namespace att {
typedef short s16x4 __attribute__((ext_vector_type(4)));
constexpr int KVBLK = 64, SHM_V = KVBLK * 128 * 2, SHM_K = KVBLK * 128 * 2;
constexpr int OFF_V = 0, OFF_K = 2 * SHM_V, OFF_WS = OFF_K + 2 * SHM_K, OFF_BL = OFF_WS + 8 * 64 * 4, LDS_ATT = OFF_BL + 2 * 128 * 4;
constexpr float THR = 8.f;
#define AT_KSWZ(row, colB) ((row) * 256 + ((colB) ^ (((row) & 15) << 4)))
#define AT_SBAR() __builtin_amdgcn_sched_barrier(0)
__device__ __forceinline__ int crow(int r, int hi) { return (r & 3) + 8 * (r >> 2) + 4 * hi; }
__device__ __forceinline__ unsigned cvtpk(float lo, float hi) { unsigned r; asm volatile("v_cvt_pk_bf16_f32 %0, %1, %2" : "=v"(r) : "v"(lo), "v"(hi)); return r; }

__device__ __forceinline__ void partialSM(f32x16& p0, f32x16& p1, float& m_reg, float& alpha) {
    float pmax = p0[0];
#pragma unroll
    for (int r = 1; r < 16; ++r) pmax = fmaxf(pmax, p0[r]);
#pragma unroll
    for (int r = 0; r < 16; ++r) pmax = fmaxf(pmax, p1[r]);
    { auto rr = __builtin_amdgcn_permlane32_swap(__float_as_uint(pmax), __float_as_uint(pmax), false, false); pmax = fmaxf(__uint_as_float(rr[0]), __uint_as_float(rr[1])); }
    float mn;
    if (__builtin_expect(__all(pmax - m_reg <= THR), 1)) { mn = m_reg; alpha = 1.f; }
    else { mn = fmaxf(m_reg, pmax); alpha = __builtin_amdgcn_exp2f(m_reg - mn); m_reg = mn; }
#pragma unroll
    for (int r = 0; r < 16; ++r) { p0[r] -= mn; p1[r] -= mn; }
#pragma unroll
    for (int r = 0; r < 16; ++r) p0[r] = __builtin_amdgcn_exp2f(p0[r]);
}
__device__ __forceinline__ void finishSM(f32x16& p0, f32x16& p1, float alpha, float& l_reg, bf16x8& pa0, bf16x8& pa1, bf16x8& pa2, bf16x8& pa3) {
#pragma unroll
    for (int r = 0; r < 16; ++r) p1[r] = __builtin_amdgcn_exp2f(p1[r]);
    float ps = 0.f;
#pragma unroll
    for (int r = 0; r < 16; ++r) ps += p0[r];
#pragma unroll
    for (int r = 0; r < 16; ++r) ps += p1[r];
    { auto rr = __builtin_amdgcn_permlane32_swap(__float_as_uint(ps), __float_as_uint(ps), false, false); ps = __uint_as_float(rr[0]) + __uint_as_float(rr[1]); }
    l_reg = l_reg * alpha + ps;
#define AT_PK4(Pv, BASE, OUT) do { unsigned a0 = cvtpk(Pv[BASE + 0], Pv[BASE + 1]), a1 = cvtpk(Pv[BASE + 2], Pv[BASE + 3]);   \
    unsigned b0 = cvtpk(Pv[BASE + 4], Pv[BASE + 5]), b1 = cvtpk(Pv[BASE + 6], Pv[BASE + 7]);                              \
    auto r0 = __builtin_amdgcn_permlane32_swap(a0, b0, false, false); auto r1 = __builtin_amdgcn_permlane32_swap(a1, b1, false, false); \
    u32x4 w = {r0[0], r1[0], r0[1], r1[1]}; OUT = __builtin_bit_cast(bf16x8, w); } while (0)
    AT_PK4(p0, 0, pa0); AT_PK4(p0, 8, pa1); AT_PK4(p1, 0, pa2); AT_PK4(p1, 8, pa3);
#undef AT_PK4
}
__device__ __forceinline__ void qkt(f32x16& p0, f32x16& p1, const LAS char* Ks, const bf16x8* qr, int kb) {
    p0 = f32x16{}; p1 = f32x16{};
#pragma unroll
    for (int d0 = 0; d0 < 4; ++d0) {
        const bf16x8 b0 = *(const LAS bf16x8*)(Ks + (kb ^ (d0 * 32)));
        const bf16x8 b1 = *(const LAS bf16x8*)(Ks + 32 * 256 + (kb ^ (d0 * 32)));
        p0 = __builtin_amdgcn_mfma_f32_32x32x16_bf16(b0, qr[d0], p0, 0, 0, 0);
        p1 = __builtin_amdgcn_mfma_f32_32x32x16_bf16(b1, qr[d0], p1, 0, 0, 0); }
}
__device__ __forceinline__ void adj(f32x16& p0, f32x16& p1, int q, int k0, int hi, const LAS float* bl) {
#pragma unroll
    for (int r = 0; r < 16; ++r) { const int rel0 = q - (k0 + crow(r, hi)), rel1 = rel0 - 32;
        const float b0 = bl[min(max(rel0, 0), 127)], b1 = bl[min(max(rel1, 0), 127)];
        p0[r] = rel0 >= 0 ? p0[r] + b0 : -1e30f; p1[r] = rel1 >= 0 ? p1[r] + b1 : -1e30f; }
}
__device__ __forceinline__ int v_st(int k, int c) { const int kk = (k & ~0xC) | ((k & 4) << 1) | ((k & 8) >> 1); return ((kk >> 3) * 4 + (c >> 5)) * 512 + ((kk & 7) * 32 + (c & 31)) * 2; }
__device__ __forceinline__ int v_rd_base(int lane) { return ((lane & 3) << 3) | (((lane >> 2) & 3) << 6) | (((lane >> 4) & 1) << 5) | (((lane >> 5) & 1) << 8); }
constexpr int v_rd_off(int d0, int ks, int half) { return d0 * 512 + ks * 4096 + half * 2048; }
template <int OFF> __device__ __forceinline__ s16x4 tr_read(int vb) { s16x4 r; asm volatile("ds_read_b64_tr_b16 %0, %1 offset:%2" : "=&v"(r) : "v"(vb), "i"(OFF) : "memory"); return r; }
template <int D0> __device__ __forceinline__ void pv_one(f32x16& od, int vb, bf16x8 pa0, bf16x8 pa1, bf16x8 pa2, bf16x8 pa3) {
    const s16x4 l0 = tr_read<v_rd_off(D0, 0, 0)>(vb), h0 = tr_read<v_rd_off(D0, 0, 1)>(vb), l1 = tr_read<v_rd_off(D0, 1, 0)>(vb), h1 = tr_read<v_rd_off(D0, 1, 1)>(vb);
    const s16x4 l2 = tr_read<v_rd_off(D0, 2, 0)>(vb), h2 = tr_read<v_rd_off(D0, 2, 1)>(vb), l3 = tr_read<v_rd_off(D0, 3, 0)>(vb), h3 = tr_read<v_rd_off(D0, 3, 1)>(vb);
    asm volatile("s_waitcnt lgkmcnt(0)" ::: "memory"); AT_SBAR();
#define AT_PK(L, H) (bf16x8){L[0], L[1], L[2], L[3], H[0], H[1], H[2], H[3]}
    od = __builtin_amdgcn_mfma_f32_32x32x16_bf16(pa0, AT_PK(l0, h0), od, 0, 0, 0);
    od = __builtin_amdgcn_mfma_f32_32x32x16_bf16(pa1, AT_PK(l1, h1), od, 0, 0, 0);
    od = __builtin_amdgcn_mfma_f32_32x32x16_bf16(pa2, AT_PK(l2, h2), od, 0, 0, 0);
    od = __builtin_amdgcn_mfma_f32_32x32x16_bf16(pa3, AT_PK(l3, h3), od, 0, 0, 0);
#undef AT_PK
}
__device__ __forceinline__ void pv_d0(f32x16* o, int vb, bf16x8 pa0, bf16x8 pa1, bf16x8 pa2, bf16x8 pa3) {
    pv_one<0>(o[0], vb, pa0, pa1, pa2, pa3); pv_one<1>(o[1], vb, pa0, pa1, pa2, pa3); pv_one<2>(o[2], vb, pa0, pa1, pa2, pa3); pv_one<3>(o[3], vb, pa0, pa1, pa2, pa3);
}

__device__ __forceinline__ void attn_unit(int b, int h, int qb, const bf16_t* __restrict__ P, bf16_t* MIX, const float* rel_bias, const float* subln, float lam, float osc, LAS char* lds, int tid) {
    const int wid = __builtin_amdgcn_readfirstlane(tid >> 6), lane = tid & 63, r32 = lane & 31, hi = lane >> 5, jm = wid >> 2, w4 = wid & 3;
    LAS char* V_lds = lds + OFF_V; LAS char* K_lds = lds + OFF_K;
    LAS float* wsf = (LAS float*)(lds + OFF_WS) + wid * 64; LAS float* li_l = wsf; LAS float* al_l = wsf + 32;
    LAS float* bl = (LAS float*)(lds + OFF_BL);
    const int q0 = qb * 128, qw = q0 + w4 * 32, qpos = qw + r32;
    const size_t rowb = (size_t)b * S;
    if (tid < 256) { const int j = tid >> 7, d = tid & 127; bl[tid] = (rel_bias[(int)T5B[d] * 16 + 2 * h + j] - rel_bias[31 * 16 + 2 * h + j]) * LOG2E; }
    float m_reg = -1e30f, l_reg = 0.f; f32x16 o[4] = {}; bf16x8 qr[4];
    { const bf16_t* Qw = P + (rowb + qpos) * INC + C_QD + h * 128 + jm * 64 + hi * 8;
#pragma unroll
      for (int d0 = 0; d0 < 4; ++d0) qr[d0] = *(const bf16x8*)(Qw + d0 * 16); }
    const __amdgpu_buffer_rsrc_t rs = __builtin_amdgcn_make_buffer_rsrc((void*)((const char*)P + (rowb * INC + C_KD + h * 128) * 2), 0, (int)((size_t)S * INC * 2), 0x00020000);
    const int sr = tid >> 4, sc = (tid & 15) * 8, vst0 = v_st(sr, sc), vst1 = v_st(32 + sr, sc);
    const unsigned voff = (unsigned)(sr * INC + sc) * 2u;
    const int kst0 = AT_KSWZ(sr, sc * 2), kst1 = AT_KSWZ(32 + sr, sc * 2);
    const int vb0 = (int)(uintptr_t)V_lds + v_rd_base(lane);
    const int kb = AT_KSWZ(r32, jm * 128 + hi * 16);
    const LAS float* blj = bl + jm * 128;
    struct { bf16x8 vs0, vs1, ks0, ks1; } sr_[2];
#define AT_BL(so) __builtin_bit_cast(bf16x8, __builtin_amdgcn_raw_buffer_load_b128(rs, voff, (so), 0))
#define AT_SLOAD(i, k0) do { const int so_ = (k0) * (INC * 2); \
    sr_[i].vs0 = AT_BL(so_ + (C_VD - C_KD) * 2); sr_[i].vs1 = AT_BL(so_ + (C_VD - C_KD) * 2 + 32 * INC * 2); \
    sr_[i].ks0 = AT_BL(so_); sr_[i].ks1 = AT_BL(so_ + 32 * INC * 2); } while (0)
#define AT_SWRITE(bf, i) do { *(LAS bf16x8*)(V_lds + (bf) * SHM_V + vst0) = sr_[i].vs0; *(LAS bf16x8*)(V_lds + (bf) * SHM_V + vst1) = sr_[i].vs1; \
    *(LAS bf16x8*)(K_lds + (bf) * SHM_K + kst0) = sr_[i].ks0; *(LAS bf16x8*)(K_lds + (bf) * SHM_K + kst1) = sr_[i].ks1; } while (0)
#define AT_SWAIT() asm volatile("s_waitcnt vmcnt(4)" ::: "memory")
#define AT_RESC(a) do { if (__any((a) < 1.f)) { if (hi == 0) al_l[r32] = (a); asm volatile("s_waitcnt lgkmcnt(0)" ::: "memory"); \
    _Pragma("unroll") for (int d = 0; d < 4; ++d) _Pragma("unroll") for (int r = 0; r < 16; ++r) o[d][r] *= al_l[crow(r, hi)]; } } while (0)
#define AT_ADJ(PA, PB, t) do { const int k0_ = (t) * KVBLK; if (qw - (k0_ + 63) < 113) adj(PA, PB, qpos, k0_, hi, blj); } while (0)
    f32x16 pA0, pA1, pB0, pB1; float alA, alB; bf16x8 pa0, pa1, pa2, pa3; const int NT = 2 * qb + 2;
    AT_SLOAD(0, 0); asm volatile("s_waitcnt vmcnt(0)" ::: "memory"); AT_SWRITE(0, 0); __syncthreads();
    qkt(pA0, pA1, K_lds, qr, kb); AT_ADJ(pA0, pA1, 0); partialSM(pA0, pA1, m_reg, alA);
    AT_SLOAD(1, KVBLK); if (2 < NT) AT_SLOAD(0, 2 * KVBLK);
    AT_SWAIT(); AT_SWRITE(1, 1); __syncthreads();
    for (int j = 1; j + 1 < NT; j += 2) {
        AT_SBAR(); qkt(pB0, pB1, K_lds + SHM_K, qr, kb);
        finishSM(pA0, pA1, alA, l_reg, pa0, pa1, pa2, pa3); AT_SBAR();
        AT_SLOAD(1, (j + 2) * KVBLK); AT_SBAR();
        pv_d0(o, vb0, pa0, pa1, pa2, pa3); AT_ADJ(pB0, pB1, j); partialSM(pB0, pB1, m_reg, alB);
        __syncthreads(); AT_SWAIT(); AT_SWRITE(0, 0);
        AT_RESC(alB); __syncthreads();
        AT_SBAR(); qkt(pA0, pA1, K_lds, qr, kb);
        finishSM(pB0, pB1, alB, l_reg, pa0, pa1, pa2, pa3); AT_SBAR();
        if (j + 3 < NT) AT_SLOAD(0, (j + 3) * KVBLK); AT_SBAR();
        pv_d0(o, vb0 + SHM_V, pa0, pa1, pa2, pa3); AT_ADJ(pA0, pA1, j + 1); partialSM(pA0, pA1, m_reg, alA);
        __syncthreads(); AT_SWAIT(); AT_SWRITE(1, 1);
        AT_RESC(alA); __syncthreads();
    }
    AT_SBAR(); qkt(pB0, pB1, K_lds + SHM_K, qr, kb);
    finishSM(pA0, pA1, alA, l_reg, pa0, pa1, pa2, pa3); AT_SBAR();
    pv_d0(o, vb0, pa0, pa1, pa2, pa3); AT_ADJ(pB0, pB1, NT - 1); partialSM(pB0, pB1, m_reg, alB);
    __syncthreads(); AT_RESC(alB);
    finishSM(pB0, pB1, alB, l_reg, pa0, pa1, pa2, pa3); AT_SBAR();
    pv_d0(o, vb0 + SHM_V, pa0, pa1, pa2, pa3);
    int t2 = tid; asm volatile("" : "+v"(t2));
    const int lane2 = t2 & 63, r32b = lane2 & 31, hib = lane2 >> 5;
    if (hib == 0) li_l[r32b] = l_reg; asm volatile("s_waitcnt lgkmcnt(0)" ::: "memory");
    float rli[16];
#pragma unroll
    for (int r = 0; r < 16; ++r) rli[r] = __builtin_amdgcn_rcpf(li_l[crow(r, hib)]);
    __syncthreads();
    LAS float* xch = (LAS float*)lds + (w4 * 64) * 64 + lane2;
    if (jm == 1) {
#pragma unroll
        for (int d0 = 0; d0 < 4; ++d0)
#pragma unroll
            for (int r = 0; r < 16; ++r) xch[(d0 * 16 + r) * 64] = o[d0][r] * rli[r] * lam; }
    __syncthreads();
    if (jm == 0) {
#pragma unroll
        for (int r = 0; r < 16; ++r) { float a = 0.f;
#pragma unroll
            for (int d0 = 0; d0 < 4; ++d0) { const float dv = o[d0][r] * rli[r] - xch[(d0 * 16 + r) * 64]; o[d0][r] = dv; a += dv * dv; }
#pragma unroll
            for (int m = 1; m < 32; m <<= 1) a += __shfl_xor(a, m);
            rli[r] = rsqrtf(a * (1.f / 128.f) + EPS) * osc; }
        float sg[4];
#pragma unroll
        for (int d0 = 0; d0 < 4; ++d0) sg[d0] = subln[32 * d0 + r32b];
        bf16_t* Ow = MIX + (rowb + qw) * D + h * 128 + r32b;
#pragma unroll
        for (int r = 0; r < 16; ++r) { const int orow = crow(r, hib);
#pragma unroll
            for (int d0 = 0; d0 < 4; ++d0) Ow[(size_t)orow * D + d0 * 32] = (bf16_t)f2bf(o[d0][r] * rli[r] * sg[d0]); }
    }
    __syncthreads();
#undef AT_SLOAD
#undef AT_BL
#undef AT_SWRITE
#undef AT_SWAIT
#undef AT_RESC
#undef AT_ADJ
}
#undef AT_KSWZ
#undef AT_SBAR
}

#define MIXER_PHASES \
        if (IN(PH_ATT)) { PHASE_LOCALS \
            const float lam = LAM[l]; const float osc = 1.f - (0.8f - 0.6f * expf(-0.3f * (float)l)); \
            for (int pr = wg; pr < 256; pr += G) { const int vcu = (pr & 7) * 32 + (pr >> 3), bh = vcu >> 4, s = vcu & 15; \
                _Pragma("unroll 1") for (int u2 = 0; u2 < 2; ++u2) \
                    att::attn_unit(bh >> 3, bh & 7, u2 ? s : 31 - s, P, MIX, args.in[15], args.in[12] + l * 128, lam, osc, (LAS char*)lds, tid); } \
            GRID_BAR(); }
constexpr int NWAVES = 8, NTHR = NWAVES * 64;
constexpr size_t MiB = 1u << 20;
constexpr size_t WS_CTL = 0, CTL_ZERO_BYTES = 1 * MiB;
constexpr size_t WS_MOD = 1 * MiB;
constexpr size_t WS_LB = WS_MOD + 512 * 1024;
constexpr size_t WS_LAM = WS_LB + 16 * 1024;
constexpr size_t WS_SEL = 2 * MiB;
constexpr size_t WS_SELPOS = WS_SEL + 64 * 1024, WS_ROWW = WS_SEL + 128 * 1024, WS_ROWTOK = WS_ROWW + 512 * 1024;
constexpr size_t WS_WIN = 4 * MiB;
constexpr size_t WS_WOUT = WS_WIN + (size_t)DEPTH * INC * D * 2;
constexpr size_t WS_WGU = WS_WOUT + (size_t)DEPTH * D * D * 2;
constexpr size_t WS_WD = WS_WGU + (size_t)DEPTH * NE * 1024 * D * 2;
constexpr size_t WS_X = WS_WD + (size_t)DEPTH * NE * D * DE * 2;
constexpr size_t WS_HB = WS_X + (size_t)T * D * 4;
constexpr size_t WS_P = WS_HB + (size_t)T * D * 2;
constexpr size_t WS_LF = WS_P + (size_t)T * INC * 2;
constexpr size_t WS_MIX = WS_LF + (size_t)T * 1024 * 4;
constexpr size_t WS_KV = WS_MIX + (size_t)T * D * 2;
constexpr size_t WS_DEC = WS_KV + (size_t)NB * 8 * NCH * 128 * 128 * 4;
constexpr size_t WS_ST = WS_DEC + (size_t)NB * 8 * NCH * 128 * 4;
constexpr size_t WS_ACT = WS_ST + (size_t)NB * 8 * NCH * 128 * 128 * 2;
constexpr size_t WS_Y1 = WS_ACT + (size_t)20480 * DE * 2;
constexpr size_t WS_HRAW = WS_Y1 + (size_t)T * D * 2;
constexpr size_t WS_END = WS_HRAW + (size_t)T * 1024 * 4;
constexpr int CW_TMO = 0;
constexpr int CW_CNT = 64;
constexpr int CW_BAR = 4096;

constexpr int RING_BYTES = 131072, LDSCTL_OFF = RING_BYTES, LDS_TB_OFF = LDSCTL_OFF + 64, MISC_OFF = LDSCTL_OFF + 320, LDS_BYTES = 147456;

#define RLX_AGENT __ATOMIC_RELAXED, __HIP_MEMORY_SCOPE_AGENT
#define LDS_WAIT() asm volatile("s_waitcnt lgkmcnt(0)" ::: "memory")
#define VM_WAIT() asm volatile("s_waitcnt vmcnt(0)" ::: "memory")

#define XB_TMO      128
#define XB_XCNT(j)  (256  + 64 * (j))
#define XB_XSUB(j)  (1280 + 64 * (j))
#define XB_XGEN(j)  (2304 + 64 * (j))
#define XB_TOP      3328
#define XB_TOPGEN   3392
#define XCD_BAR_WORDS 3456
#define XB_SPIN_CAP (1u << 22)
__device__ __forceinline__ unsigned xb_ld(unsigned* p)              { return __hip_atomic_load(p, __ATOMIC_RELAXED, __HIP_MEMORY_SCOPE_AGENT); }
__device__ __forceinline__ unsigned xb_add(unsigned* p, unsigned v) { return __hip_atomic_fetch_add(p, v, __ATOMIC_RELAXED, __HIP_MEMORY_SCOPE_AGENT); }
__device__ __forceinline__ unsigned xb_xcc_id() { return (unsigned)__builtin_amdgcn_s_getreg((3 << 11) | 20) & 0xFu; }
#define XB_SPIN(cond, bar) do { unsigned _sp = 0; while (cond) { __builtin_amdgcn_s_sleep(1); \
    if ((++_sp & 255u) == 0u) { if (xb_ld(&(bar)[XB_TMO])) break; if (_sp > XB_SPIN_CAP) { atomicAdd(&(bar)[XB_TMO], 1u); break; } } } } while (0)
struct XcdBarrier { unsigned* bar; unsigned x; volatile LAS unsigned* st; };
__device__ __forceinline__ XcdBarrier xcd_barrier_post(unsigned* bar, volatile LAS unsigned* st) {
    XcdBarrier b; b.bar = bar; b.x = xb_xcc_id(); b.st = st;
    if (threadIdx.x == 0) (void)xb_add(&bar[XB_XCNT(b.x)], 1u);
    return b;
}
__device__ __forceinline__ void xcd_barrier_complete(unsigned* bar, unsigned x, unsigned& nloc, unsigned& nx) {
    const unsigned G = gridDim.x * gridDim.y * gridDim.z;
    unsigned sum, cnt, mine, sp = 0u;
    for (;;) {
        sum = 0u; cnt = 0u; mine = 0u;
#pragma unroll
        for (unsigned j = 0; j < 16; ++j) { const unsigned c = xb_ld(&bar[XB_XCNT(j)]); sum += c; cnt += (c > 0u) ? 1u : 0u; mine = (j == x) ? c : mine; }
        if (sum == G) break;
        __builtin_amdgcn_s_sleep(1);
        if ((++sp & 255u) == 0u) { if (xb_ld(&bar[XB_TMO])) break; if (sp > XB_SPIN_CAP) { atomicAdd(&bar[XB_TMO], 1u); break; } }
    }
    nloc = mine > 0u ? mine : 1u; nx = cnt > 0u ? cnt : 1u;
}
__device__ __forceinline__ void xcd_barrier(const XcdBarrier& b) {
    asm volatile("s_waitcnt vmcnt(0)" ::: "memory");
    __syncthreads();
    if (threadIdx.x == 0) {
        unsigned* bar = b.bar;
        __builtin_amdgcn_s_waitcnt(0);
        unsigned nloc = b.st[0], nx = b.st[1];
        if (nloc == 0u) { xcd_barrier_complete(bar, b.x, nloc, nx); b.st[0] = nloc; b.st[1] = nx; }
        const unsigned old = xb_add(&bar[XB_XSUB(b.x)], 1u);
        const unsigned gen = old / nloc;
        if (old + 1u == (gen + 1u) * nloc) {
            __builtin_amdgcn_fence(__ATOMIC_RELEASE, "agent");
            asm volatile("s_waitcnt vmcnt(0)" ::: "memory");
            const unsigned og = xb_add(&bar[XB_TOP], 1u);
            const unsigned tg = og / nx;
            if (og + 1u == (tg + 1u) * nx) xb_add(&bar[XB_TOPGEN], 1u);
            else XB_SPIN(xb_ld(&bar[XB_TOPGEN]) == tg, bar);
            __builtin_amdgcn_fence(__ATOMIC_ACQUIRE, "agent");
            xb_add(&bar[XB_XGEN(b.x)], 1u);
            asm volatile("s_waitcnt vmcnt(0)" ::: "memory");
        } else {
            XB_SPIN(xb_ld(&bar[XB_XGEN(b.x)]) == gen, bar);
            __builtin_amdgcn_fence(__ATOMIC_ACQUIRE, "agent");
            asm volatile("s_waitcnt vmcnt(0)" ::: "memory");
        }
    }
    __syncthreads();
}

__device__ __forceinline__ void transpose_item(const float* W, int K, int N, bf16_t* WT, int k0, int n0, int drow0, LAS float* scr, int lane) {
#pragma unroll 8
    for (int i = 0; i < 32; ++i) { const int kk = 2 * i + (lane >> 5); scr[kk * 33 + (lane & 31)] = W[(size_t)(k0 + kk) * N + n0 + (lane & 31)]; }
    LDS_WAIT(); asm volatile("" ::: "memory");
    const int c = lane & 7;
#pragma unroll
    for (int j = 0; j < 4; ++j) { const int n = (lane >> 3) + 8 * j; const LAS float* s = scr + (8 * c) * 33 + n;
        u32x4 o; o.x = pk2(s[0 * 33], s[1 * 33]); o.y = pk2(s[2 * 33], s[3 * 33]); o.z = pk2(s[4 * 33], s[5 * 33]); o.w = pk2(s[6 * 33], s[7 * 33]);
        *(u32x4*)(WT + (size_t)(drow0 + n) * K + k0 + 8 * c) = o; }
    LDS_WAIT(); asm volatile("" ::: "memory");
}

struct Args { const float* in[22]; float* out; unsigned char* ws; int l_lo, l_hi, ph_lo, ph_hi, one, pad; };
enum { PH_PRO = 0, PH_NORM1 = 1, PH_PROJ = 2, PH_ATT = 3, PH_SCAN = 4, PH_HG3 = 5, PH_OUT = 6, PH_ROUTE = 7, PH_UP = 8, PH_DOWN = 9, PH_FINAL = 10 };

template <bool ROUTER>
__device__ __forceinline__ void norm_rows(const Args& args, unsigned char* ws, int l, int wg, int tid, int wave, int lane, LAS unsigned char* lds, bool addy, const float* gain, int shift_idx, int scale_idx) {
    float* Xp = (float*)(ws + WS_X); const bf16_t* Y1p = (const bf16_t*)(ws + WS_Y1); bf16_t* HBp = (bf16_t*)(ws + WS_HB);
    const float* modl = (const float*)(ws + WS_MOD) + (size_t)l * NB * MODW;
    const int row0 = wg * 32, b = row0 / S;
    const float* sh = modl + b * MODW + shift_idx * D; const float* sc = modl + b * MODW + scale_idx * D;
    LAS float* wr = (LAS float*)lds;
    if (ROUTER) {
        const float* w_router = args.in[16];
        for (int i = tid; i < D * NE / 4; i += NTHR) { const f32x4 v = *(const f32x4*)(w_router + 4 * i); const int j = i >> 2, e = (i & 3) * 4;
            wr[(e + 0) * D + j] = v[0]; wr[(e + 1) * D + j] = v[1]; wr[(e + 2) * D + j] = v[2]; wr[(e + 3) * D + j] = v[3]; }
        __syncthreads();
    }
    f32x4 ga[8], sv[8];
#pragma unroll
    for (int j = 0; j < 8; ++j) { const int c = 4 * lane + 256 * j; const f32x4 g = *(const f32x4*)(gain + c), s1 = *(const f32x4*)(sc + c); ga[j] = g * (s1 + 1.f); sv[j] = *(const f32x4*)(sh + c); }
    for (int i = 0; i < 4; ++i) {
        const int row = row0 + wave + 8 * i;
        float* xr = Xp + (size_t)row * D;
        f32x4 v[8]; float ss = 0.f;
#pragma unroll
        for (int j = 0; j < 8; ++j) { const int c = 4 * lane + 256 * j; v[j] = *(const f32x4*)(xr + c);
            if (addy) { const u32x2 y = *(const u32x2*)(Y1p + (size_t)row * D + c); v[j][0] += bflo(y.x); v[j][1] += bfhi(y.x); v[j][2] += bflo(y.y); v[j][3] += bfhi(y.y); *(f32x4*)(xr + c) = v[j]; }
            ss += (v[j][0] * v[j][0] + v[j][1] * v[j][1]) + (v[j][2] * v[j][2] + v[j][3] * v[j][3]); }
        const float r = rsqrtf(wave_sum(ss) * (1.f / D) + EPS);
#pragma unroll
        for (int j = 0; j < 8; ++j) { const int c = 4 * lane + 256 * j; v[j] = v[j] * r * ga[j] + sv[j];
            u32x2 o; o.x = pk2(v[j][0], v[j][1]); o.y = pk2(v[j][2], v[j][3]); *(u32x2*)(HBp + (size_t)row * D + c) = o; }
        if (ROUTER) {
            float mine = 0.f;
#pragma unroll 1
            for (int e = 0; e < NE; ++e) { float a = 0.f;
#pragma unroll
                for (int j = 0; j < 8; ++j) { const f32x4 w = *(const LAS f32x4*)(wr + e * D + 4 * lane + 256 * j); a += (v[j][0] * w[0] + v[j][1] * w[1]) + (v[j][2] * w[2] + v[j][3] * w[3]); }
                a = wave_sum(a); if (lane == e) mine = a; }
            float p[NE];
#pragma unroll
            for (int e = 0; e < NE; ++e) p[e] = __shfl(mine, e);
            if (lane == 0) {
                const float* b_router = args.in[17];
                float m = -1e30f;
#pragma unroll
                for (int e = 0; e < NE; ++e) { p[e] += b_router[e]; m = fmaxf(m, p[e]); }
                float s = 0.f;
#pragma unroll
                for (int e = 0; e < NE; ++e) { p[e] = expf(p[e] - m); s += p[e]; }
#pragma unroll
                for (int e = 0; e < NE; ++e) p[e] /= s;
                int gs = 0; float best = -1.f;
#pragma unroll
                for (int g = 0; g < 4; ++g) { float a = -1.f, c2 = -1.f;
#pragma unroll
                    for (int q = 0; q < 4; ++q) { const float pv = p[g * 4 + q]; if (pv > a) { c2 = a; a = pv; } else if (pv > c2) c2 = pv; }
                    if (a + c2 > best) { best = a + c2; gs = g; } }
                float q4[4];
#pragma unroll
                for (int q = 0; q < 4; ++q) q4[q] = gs == 0 ? p[q] : gs == 1 ? p[4 + q] : gs == 2 ? p[8 + q] : p[12 + q];
                int e0 = -1, e1 = -1; float v0 = -2.f, v1 = -2.f;
#pragma unroll
                for (int q = 0; q < 4; ++q) { const float pv = q4[q]; if (pv > v0) { v1 = v0; e1 = e0; v0 = pv; e0 = gs * 4 + q; } else if (pv > v1) { v1 = pv; e1 = gs * 4 + q; } }
                const float den = v0 + v1;
                unsigned* cnt = (unsigned*)(ws + WS_CTL) + CW_CNT + 64 * l;
                const int p0 = (int)atomicAdd(&cnt[e0], 1u), p1 = (int)atomicAdd(&cnt[e1], 1u);
                float* roww = (float*)(ws + WS_ROWW); int* rowtok = (int*)(ws + WS_ROWTOK);
                roww[e0 * T + p0] = v0 / den; roww[e1 * T + p1] = v1 / den; rowtok[e0 * T + p0] = row; rowtok[e1 * T + p1] = row | (int)0x80000000;
            }
        }
    }
}

__global__ void __launch_bounds__(NTHR, 2) mk_fwd(Args args) {
    extern __shared__ __attribute__((aligned(16))) unsigned char lds_raw[];
    LAS unsigned char* lds = (LAS unsigned char*)lds_raw;
    const int G = gridDim.x, wg = blockIdx.x;
    XcdBarrier bar;
    {
        const int tid = threadIdx.x; unsigned* ctl = (unsigned*)(args.ws + WS_CTL);
        volatile LAS unsigned* MISC = (volatile LAS unsigned*)(lds + MISC_OFF);
        for (int u = tid; u < (LDS_BYTES - LDSCTL_OFF) / 4; u += NTHR) ((LAS unsigned*)(lds + LDSCTL_OFF))[u] = 0u;
        __syncthreads();
        bar.bar = ctl + CW_BAR; bar.x = 0; bar.st = nullptr;
        if (args.one) bar = xcd_barrier_post(ctl + CW_BAR, MISC + 8);
    }
#define GRID_BAR() do { if (args.one) xcd_barrier(bar); } while (0)
#define IN(k) (args.ph_lo <= (k) && (k) < args.ph_hi)
#define X ((float*)(ws + WS_X))
#define HB ((bf16_t*)(ws + WS_HB))
#define P ((bf16_t*)(ws + WS_P))
#define LF ((float*)(ws + WS_LF))
#define MIX ((bf16_t*)(ws + WS_MIX))
#define ACT ((bf16_t*)(ws + WS_ACT))
#define Y1 ((bf16_t*)(ws + WS_Y1))
#define MOD ((float*)(ws + WS_MOD))
#define LB ((float*)(ws + WS_LB))
#define LAM ((float*)(ws + WS_LAM))
#define PHASE_LOCALS unsigned char* ws = args.ws; asm volatile("" : "+s"(ws)); int tid = threadIdx.x; asm volatile("" : "+v"(tid)); \
    const int lane = tid & 63, wave = __builtin_amdgcn_readfirstlane(tid >> 6); (void)lane; (void)wave; unsigned* ctl = (unsigned*)(ws + WS_CTL); (void)ctl;

#ifndef NO_PRO
    if (args.l_lo == 0 && IN(PH_PRO)) { PHASE_LOCALS
        if (wg == 0) {
            for (int j = tid; j < 1024; j += NTHR) { const float* hl = args.in[13]; float v[DEPTH], m = -1e30f;
                for (int l = 0; l < DEPTH; ++l) { v[l] = hl[l * 1024 + j]; m = fmaxf(m, v[l]); }
                float s = 0.f; for (int l = 0; l < DEPTH; ++l) { v[l] = expf(v[l] - m); s += v[l]; }
                float cum = 0.f; const float s0 = v[0] / s;
                for (int l = 0; l < DEPTH; ++l) { cum += v[l] / s; LB[l * 1024 + j] = fmaxf(cum - s0, 0.f); } }
            if (tid < DEPTH) { float a = 0.f, b = 0.f;
                for (int i = 0; i < 64; ++i) { a += args.in[8][tid * 64 + i] * args.in[9][tid * 64 + i]; b += args.in[10][tid * 64 + i] * args.in[11][tid * 64 + i]; }
                LAM[tid] = expf(a) - expf(b) + (0.8f - 0.6f * expf(-0.3f * (float)tid)); }
        }
        {
            LAS float* ca = (LAS float*)lds; LAS float* red = ca + NB * D;
            for (int i = tid; i < NB * D; i += NTHR) ca[i] = siluf_(args.in[1][i]);
            __syncthreads();
            for (int item = wg; item < DEPTH * 64; item += G) {
                const int l = item >> 6, c0 = (item & 63) * 192;
                if (tid < 384) { const int cg = tid % 48, ks = tid / 48; const float* w = args.in[6] + (size_t)l * D * MODW + c0 + 4 * cg;
                    f32x4 a0 = {0.f, 0.f, 0.f, 0.f}, a1 = a0;
#pragma unroll 8
                    for (int k = ks * 256; k < ks * 256 + 256; ++k) { const f32x4 wv = *(const f32x4*)(w + (size_t)k * MODW); a0 += wv * ca[k]; a1 += wv * ca[D + k]; }
#pragma unroll
                    for (int q = 0; q < 4; ++q) { red[(ks * 2 + 0) * 192 + 4 * cg + q] = a0[q]; red[(ks * 2 + 1) * 192 + 4 * cg + q] = a1[q]; } }
                __syncthreads();
                if (tid < 384) { const int b = tid / 192, c = tid % 192; float s = args.in[7][l * MODW + c0 + c];
                    for (int ks = 0; ks < 8; ++ks) s += red[(ks * 2 + b) * 192 + c];
                    MOD[(size_t)(l * NB + b) * MODW + c0 + c] = s; }
                __syncthreads();
            }
        }
        {
            LAS float* scr = (LAS float*)(lds + wave * 16384);
            const int gw = wg * NWAVES + wave, NGW = G * NWAVES;
            constexpr int I_IN = (D / 64) * (INC / 32), I_OUT = (D / 64) * (D / 32), I_G = (D / 64) * (DE / 32), I_D = (DE / 64) * (D / 32);
            constexpr int N_IN = DEPTH * I_IN, N_OUT = DEPTH * I_OUT, N_G = DEPTH * NE * I_G, N_D = DEPTH * NE * I_D;
            for (int it = gw; it < N_IN + N_OUT + 2 * N_G + N_D; it += NGW) {
                int r = it;
                if (r < N_IN) { const int l = r / I_IN, q = r % I_IN, nblk = INC / 32, kb = q / nblk, nb = q % nblk;
                    transpose_item(args.in[2] + (size_t)l * D * INC, D, INC, (bf16_t*)(ws + WS_WIN) + (size_t)l * INC * D, 64 * kb, 32 * nb, 32 * nb, scr, lane); continue; } r -= N_IN;
                if (r < N_OUT) { const int l = r / I_OUT, q = r % I_OUT, nblk = D / 32, kb = q / nblk, nb = q % nblk;
                    transpose_item(args.in[3] + (size_t)l * D * D, D, D, (bf16_t*)(ws + WS_WOUT) + (size_t)l * D * D, 64 * kb, 32 * nb, 32 * nb, scr, lane); continue; } r -= N_OUT;
                if (r < 2 * N_G) { const int up = r >= N_G; if (up) r -= N_G; const int le = r / I_G, q = r % I_G, nblk = DE / 32, kb = q / nblk, nb = q % nblk, n0 = 32 * nb;
                    transpose_item(args.in[up ? 19 : 18] + (size_t)le * D * DE, D, DE, (bf16_t*)(ws + WS_WGU) + (size_t)le * 1024 * D, 64 * kb, n0, (n0 >> 7) * 256 + (up ? 128 : 0) + (n0 & 127), scr, lane); continue; } r -= 2 * N_G;
                { const int le = r / I_D, q = r % I_D, nblk = D / 32, kb = q / nblk, nb = q % nblk;
                    transpose_item(args.in[20] + (size_t)le * DE * D, DE, D, (bf16_t*)(ws + WS_WD) + (size_t)le * D * DE, 64 * kb, 32 * nb, 32 * nb, scr, lane); }
            }
            for (size_t i = (size_t)(wg * NTHR + tid); i < (size_t)T * D / 4; i += (size_t)G * NTHR) ((f32x4*)X)[i] = ((const f32x4*)args.in[0])[i];
        }
        GRID_BAR();
    }
#endif

    for (int l = args.l_lo; l < args.l_hi; ++l) {
#ifndef NO_NORM1
        if (IN(PH_NORM1)) { PHASE_LOCALS norm_rows<false>(args, ws, l, wg, tid, wave, lane, lds, l > 0, args.in[4] + l * D, 0, 1); GRID_BAR(); }
#endif
#ifndef NO_PROJ
        if (IN(PH_PROJ)) { PHASE_LOCALS
            pg8::Gemm g{HB, (const bf16_t*)(ws + WS_WIN) + (size_t)l * INC * D, D}; pg8::StaticOrder So; So.init(T, INC, G, wg);
            pg8::EpiProj E{P, LF, LB + l * 1024};
            pg8::gemm_phase<pg8::EpiProj, pg8::StaticOrder, false>(lds, g, So, E);
            GRID_BAR();
        }
#endif
        MIXER_PHASES
#ifndef NO_OUT
        if (IN(PH_OUT)) { PHASE_LOCALS const float* modl = MOD + (size_t)l * NB * MODW;
            pg8::Gemm g{MIX, (const bf16_t*)(ws + WS_WOUT) + (size_t)l * D * D, D}; pg8::StaticOrder So; So.init(T, D, G, wg);
            pg8::EpiResid E{X, modl + 2 * D};
            pg8::gemm_phase<pg8::EpiResid, pg8::StaticOrder, false>(lds, g, So, E);
            GRID_BAR();
        }
#endif
#ifndef NO_ROUTE
        if (IN(PH_ROUTE)) { PHASE_LOCALS norm_rows<true>(args, ws, l, wg, tid, wave, lane, lds, false, args.in[5] + l * D, 3, 4); GRID_BAR(); }
#endif
        if (IN(PH_UP) || IN(PH_DOWN)) { PHASE_LOCALS const float* modl = MOD + (size_t)l * NB * MODW; unsigned* cnt = ctl + CW_CNT + 64 * l;
            LAS int* tb = (LAS int*)(lds + LDS_TB_OFF);
            if (tid == 0) { int a = 0; for (int e = 0; e < NE; ++e) { const int n = (int)__hip_atomic_load(&cnt[e], RLX_AGENT); tb[e] = a; tb[17 + e] = n; a += (n + 255) >> 8; } tb[16] = a; }
            __syncthreads();
#ifndef NO_UP
            if (IN(PH_UP)) {
                pg8::Gemm g{HB, (const bf16_t*)(ws + WS_WGU) + (size_t)l * NE * 1024 * D, D}; pg8::MoeOrder So{tb, (const int*)(ws + WS_ROWTOK), 4, G, wg};
                pg8::EpiMoeUp E{ACT, (const float*)(ws + WS_ROWW)};
                pg8::gemm_phase<pg8::EpiMoeUp, pg8::MoeOrder, true>(lds, g, So, E);
                GRID_BAR();
            }
#endif
#ifndef NO_DOWN
            if (IN(PH_DOWN)) {
                pg8::Gemm g{ACT, (const bf16_t*)(ws + WS_WD) + (size_t)l * NE * D * DE, DE}; pg8::MoeOrder So{tb, (const int*)(ws + WS_ROWTOK), 8, G, wg};
                pg8::EpiMoeDown E{X, Y1, modl + 5 * D, (const int*)(ws + WS_ROWTOK)};
                pg8::gemm_phase<pg8::EpiMoeDown, pg8::MoeOrder, false>(lds, g, So, E);
                GRID_BAR();
            }
#endif
        }
    }
    if (args.l_hi == DEPTH && IN(PH_FINAL)) { PHASE_LOCALS
        const int row0 = wg * 32; const float* gain = args.in[21];
        f32x4 ga[8];
#pragma unroll
        for (int j = 0; j < 8; ++j) ga[j] = *(const f32x4*)(gain + 4 * lane + 256 * j);
        for (int i = 0; i < 4; ++i) { const int row = row0 + wave + 8 * i; const float* xr = X + (size_t)row * D; f32x4 v[8]; float ss = 0.f;
#pragma unroll
            for (int j = 0; j < 8; ++j) { const int c = 4 * lane + 256 * j; v[j] = *(const f32x4*)(xr + c); const u32x2 y = *(const u32x2*)(Y1 + (size_t)row * D + c);
                v[j][0] += bflo(y.x); v[j][1] += bfhi(y.x); v[j][2] += bflo(y.y); v[j][3] += bfhi(y.y); ss += (v[j][0] * v[j][0] + v[j][1] * v[j][1]) + (v[j][2] * v[j][2] + v[j][3] * v[j][3]); }
            const float r = rsqrtf(wave_sum(ss) * (1.f / D) + EPS);
#pragma unroll
            for (int j = 0; j < 8; ++j) *(f32x4*)(args.out + (size_t)row * D + 4 * lane + 256 * j) = v[j] * r * ga[j]; }
    }
#undef GRID_BAR
#undef IN
#undef X
#undef HB
#undef P
#undef LF
#undef MIX
#undef ACT
#undef Y1
#undef MOD
#undef LB
#undef LAM
}
__global__ void __launch_bounds__(256) s_attn(const bf16_t* P, const float* rel_bias, const float* lam_p, const float* subln, int layer, bf16_t* MIX) {
    __shared__ float qv[128], s1[S], s2[S], red[8], ob[2][128];
    const int q = blockIdx.x, h = blockIdx.y, b = blockIdx.z, tid = threadIdx.x;
    const size_t rowq = (size_t)(b * S + q) * INC;
    if (tid < 128) qv[tid] = bf2f(P[rowq + C_QD + h * 128 + tid]);
    __syncthreads();
    const int nk = q + 1;
    float m1 = -1e30f, m2 = -1e30f;
    for (int k = tid; k < nk; k += 256) {
        const bf16_t* kr = P + (size_t)(b * S + k) * INC + C_KD + h * 128;
        float d1 = 0.f, d2 = 0.f;
        for (int i = 0; i < 64; ++i) { d1 += qv[i] * bf2f(kr[i]); d2 += qv[64 + i] * bf2f(kr[64 + i]); }
        const int n = q - k; const int bk = n < 128 ? (int)T5B[n] : 31;
        d1 += rel_bias[bk * 16 + 2 * h] * LOG2E; d2 += rel_bias[bk * 16 + 2 * h + 1] * LOG2E;
        s1[k] = d1; s2[k] = d2; m1 = fmaxf(m1, d1); m2 = fmaxf(m2, d2);
    }
    m1 = block_max256(m1, red); m2 = block_max256(m2, red);
    float l1 = 0.f, l2 = 0.f;
    for (int k = tid; k < nk; k += 256) { const float e1 = exp2f(s1[k] - m1), e2 = exp2f(s2[k] - m2); s1[k] = e1; s2[k] = e2; l1 += e1; l2 += e2; }
    l1 = block_sum256(l1, red); l2 = block_sum256(l2, red);
    const float lam = lam_p[layer]; const float i1 = 1.f / l1, i2 = lam / l2;
    const int d = tid & 127, half = tid >> 7;
    float acc = 0.f;
    for (int k = half; k < nk; k += 2) acc += (s1[k] * i1 - s2[k] * i2) * bf2f(P[(size_t)(b * S + k) * INC + C_VD + h * 128 + d]);
    ob[half][d] = acc;
    __syncthreads();
    float o = 0.f;
    if (tid < 128) o = ob[0][tid] + ob[1][tid];
    const float ss = block_sum256(tid < 128 ? o * o : 0.f, red);
    const float lambda_init = 0.8f - 0.6f * expf(-0.3f * (float)layer);
    if (tid < 128) MIX[(size_t)(b * S + q) * D + h * 128 + tid] = (bf16_t)f2bf(o * rsqrtf(ss / 128.f + EPS) * subln[layer * 128 + tid] * (1.f - lambda_init));
}
__global__ void __launch_bounds__(128) s_hgrn(const bf16_t* P, const float* LF, float* hraw) {
    __shared__ float red[2][2][8];
    const int js = blockIdx.x, h = blockIdx.y, b = blockIdx.z, d = threadIdx.x, w = d >> 6;
    float St[8];
    for (int i = 0; i < 8; ++i) St[i] = 0.f;
    for (int t = 0; t < S; ++t) {
        const size_t row = (size_t)(b * S + t);
        const bf16_t* pr = P + row * INC;
        const float f = expf(LF[row * 1024 + h * 128 + d]), kk = bf2f(pr[C_FH + h * 128 + d]), qq = bf2f(pr[C_QH + h * 128 + d]);
        float part[8];
        for (int i = 0; i < 8; ++i) { const float vv = bf2f(pr[C_IH + h * 128 + js * 8 + i]); St[i] = f * St[i] + kk * vv; part[i] = wave_sum(qq * St[i]); }
        if ((d & 63) == 0) for (int i = 0; i < 8; ++i) red[t & 1][w][i] = part[i];
        __syncthreads();
        if (d < 8) hraw[row * 1024 + h * 128 + js * 8 + d] = red[t & 1][0][d] + red[t & 1][1][d];
    }
}
__global__ void __launch_bounds__(256) s_hgrn_post(const float* hraw, const bf16_t* P, const float* hnorm_l, bf16_t* MIX) {
    const int t = blockIdx.x, tid = threadIdx.x;
    float v[4]; float ss = 0.f;
    for (int i = 0; i < 4; ++i) { v[i] = hraw[(size_t)t * 1024 + tid * 4 + i]; ss += v[i] * v[i]; }
    for (int o = 1; o < 32; o <<= 1) ss += __shfl_xor(ss, o);
    const float r = rsqrtf(ss / 128.f + EPS);
    for (int i = 0; i < 4; ++i) { const int j = tid * 4 + i; const float sg = bf2f(P[(size_t)t * INC + C_GH + j]); MIX[(size_t)t * D + 1024 + j] = (bf16_t)f2bf(v[i] * r * hnorm_l[j & 127] * sg); }
}
extern "C" void kernel_launch(void* const* d_in, const int* in_sizes, int n_in, void* d_out, int out_size, void* d_ws, size_t ws_size, hipStream_t stream) {
    static int grid = 0;
    if (grid == 0) {
        if (n_in != 22 || in_sizes[0] != T * D || out_size != T * D || ws_size < WS_END) { fprintf(stderr, "kernel_launch: unexpected shapes / workspace (%d inputs, ws %zu, need %zu)\n", n_in, ws_size, (size_t)WS_END); grid = -1; return; }
        int dev = 0, cus = 0;
        if (hipGetDevice(&dev) != hipSuccess || hipDeviceGetAttribute(&cus, hipDeviceAttributeMultiprocessorCount, dev) != hipSuccess) { grid = -1; return; }
        if (hipFuncSetAttribute((const void*)mk_fwd, hipFuncAttributeMaxDynamicSharedMemorySize, LDS_BYTES) != hipSuccess) { fprintf(stderr, "kernel_launch: hipFuncSetAttribute failed\n"); grid = -1; return; }
        int per_cu = 0;
        if (hipOccupancyMaxActiveBlocksPerMultiprocessor(&per_cu, (const void*)mk_fwd, NTHR, LDS_BYTES) != hipSuccess || per_cu < 1) fprintf(stderr, "kernel_launch: occupancy query reports %d\n", per_cu);
        (void)hipGetLastError();
        grid = cus < 256 ? cus : 256;
        if (grid != 256) fprintf(stderr, "kernel_launch: %d CUs; this kernel is laid out for 256\n", cus);
    }
    if (grid < 0) return;
    (void)hipMemsetAsync((char*)d_ws + WS_CTL, 0, CTL_ZERO_BYTES, stream);
    Args a{};
    for (int i = 0; i < 22; ++i) a.in[i] = (const float*)d_in[i];
    a.out = (float*)d_out; a.ws = (unsigned char*)d_ws;
    unsigned char* ws = (unsigned char*)d_ws;
    auto mk = [&](int l_lo, int l_hi, int ph_lo, int ph_hi, int one) {
        a.l_lo = l_lo; a.l_hi = l_hi; a.ph_lo = ph_lo; a.ph_hi = ph_hi; a.one = one; a.pad = 0;
        hipLaunchKernelGGL(mk_fwd, dim3(grid), dim3(NTHR), LDS_BYTES, stream, a);
    };
#if MK_ONE
    mk(0, DEPTH, 0, 11, 1);
#else
    mk(0, 0, PH_PRO, PH_PRO + 1, 0);
    for (int l = 0; l < DEPTH; ++l) {
        mk(l, l + 1, PH_NORM1, PH_NORM1 + 1, 0);
        mk(l, l + 1, PH_PROJ, PH_PROJ + 1, 0);
        mk(l, l + 1, PH_ATT, PH_ATT + 1, 0);
        s_hgrn<<<dim3(16, 8, NB), 128, 0, stream>>>((const bf16_t*)(ws + WS_P), (const float*)(ws + WS_LF), (float*)(ws + WS_HRAW));
        s_hgrn_post<<<T, 256, 0, stream>>>((const float*)(ws + WS_HRAW), (const bf16_t*)(ws + WS_P), (const float*)d_in[14] + l * 128, (bf16_t*)(ws + WS_MIX));
        mk(l, l + 1, PH_OUT, PH_OUT + 1, 0);
        mk(l, l + 1, PH_ROUTE, PH_ROUTE + 1, 0);
        mk(l, l + 1, PH_UP, PH_UP + 1, 0);
        mk(l, l + 1, PH_DOWN, PH_DOWN + 1, 0);
    }
    mk(DEPTH, DEPTH, PH_FINAL, PH_FINAL + 1, 0);
#endif
}
```

```cpp
#include <hip/hip_runtime.h>
#include <cstdio>
#include <cstdint>
#include <cmath>

constexpr int NB = 2, S = 4096, D = 2048, T = NB * S, DEPTH = 4;
constexpr int INC = 7168, NMOD = 6, MODW = NMOD * D;
constexpr int NE = 16, DE = 512;
constexpr float EPS = 1e-6f;
constexpr int C_QD = 0, C_KD = 1024, C_VD = 2048, C_QH = 3072, C_FH = 4096, C_IH = 5120, C_GH = 6144;
constexpr float LOG2E = 1.4426950408889634f;
constexpr float QSCALE = 0.125f * LOG2E;
constexpr int NCH = S / 64;

typedef unsigned short bf16_t;
typedef short bf16x8 __attribute__((ext_vector_type(8)));
typedef float f32x4 __attribute__((ext_vector_type(4)));
typedef float f32x16 __attribute__((ext_vector_type(16)));
typedef unsigned u32x4 __attribute__((ext_vector_type(4)));
typedef unsigned u32x2 __attribute__((ext_vector_type(2)));
#define GAS __attribute__((address_space(1)))
#define LAS __attribute__((address_space(3)))

__device__ const unsigned char T5B[128] = {0, 1, 2, 3, 4, 5, 6, 7, 8, 9, 10, 11, 12, 13, 14, 15, 16, 16, 16, 17, 17, 18, 18, 18, 19, 19, 19, 20, 20, 20, 20, 21, 21, 21, 21, 22, 22, 22, 22, 22, 23, 23, 23, 23, 23, 23, 24, 24, 24, 24, 24, 24, 25, 25, 25, 25, 25, 25, 25, 26, 26, 26, 26, 26, 26, 26, 26, 27, 27, 27, 27, 27, 27, 27, 27, 27, 27, 28, 28, 28, 28, 28, 28, 28, 28, 28, 28, 29, 29, 29, 29, 29, 29, 29, 29, 29, 29, 29, 29, 30, 30, 30, 30, 30, 30, 30, 30, 30, 30, 30, 30, 30, 30, 31, 31, 31, 31, 31, 31, 31, 31, 31, 31, 31, 31, 31, 31, 31};

__device__ __forceinline__ float wave_sum(float v) {
#pragma unroll
    for (int o = 1; o < 64; o <<= 1) v += __shfl_xor(v, o);
    return v;
}
__device__ __forceinline__ float wave_max(float v) {
#pragma unroll
    for (int o = 1; o < 64; o <<= 1) v = fmaxf(v, __shfl_xor(v, o));
    return v;
}
__device__ __forceinline__ float block_sum256(float v, float* red) {
    v = wave_sum(v);
    __syncthreads();
    if ((threadIdx.x & 63) == 0) red[threadIdx.x >> 6] = v;
    __syncthreads();
    return red[0] + red[1] + red[2] + red[3];
}
__device__ __forceinline__ float block_max256(float v, float* red) {
    v = wave_max(v);
    __syncthreads();
    if ((threadIdx.x & 63) == 0) red[threadIdx.x >> 6] = v;
    __syncthreads();
    return fmaxf(fmaxf(red[0], red[1]), fmaxf(red[2], red[3]));
}
__device__ __forceinline__ float sigmoidf_(float x) { return 1.f / (1.f + expf(-x)); }
__device__ __forceinline__ float siluf_(float x) { return x / (1.f + expf(-x)); }
__device__ __forceinline__ unsigned f2bf(float f) { unsigned u = __builtin_bit_cast(unsigned, f); return (u + 0x7fffu + ((u >> 16) & 1u)) >> 16; }
__device__ __forceinline__ unsigned pk2(float lo, float hi) { return f2bf(lo) | (f2bf(hi) << 16); }
__device__ __forceinline__ float bf2f(unsigned short h) { return __builtin_bit_cast(float, (unsigned)h << 16); }
__device__ __forceinline__ float bflo(unsigned w) { return __builtin_bit_cast(float, w << 16); }
__device__ __forceinline__ float bfhi(unsigned w) { return __builtin_bit_cast(float, w & 0xffff0000u); }

__device__ __forceinline__ void hgrn_gate(float fr, float lbv, float& logf, float& kk) {
    const float s1 = 1.f / (1.f + expf(-fr)), s2 = 1.f / (1.f + expf(fr));
    const float f = lbv + (1.f - lbv) * s1;
    logf = __logf(fmaxf(f, 1.17549435e-38f)); kk = (1.f - lbv) * s2;
}
#ifndef MK_ONE
#define MK_ONE 1
#endif
namespace pg8 {
constexpr int BM = 256, BK = 64, HALF = 128, HTB = HALF * BK * 2  , STAGE_BYTES = 8 * HTB, NXCD = 8, WGM = 8;
__host__ __device__ __forceinline__ int lds_byte(int r, int c) { const int st = (r >> 4) * 2 + (c >> 5), rr = r & 15, cc = c & 31, ob = rr * 64 + cc * 2; return st * 1024 + (ob ^ (((ob >> 9) & 1) << 5)); }
__host__ __device__ __forceinline__ void stage_rc(int b, int& R, int& C) { const int st = b / 1024, sb = b % 1024, swz = sb ^ (((sb >> 9) & 1) << 5); R = (st >> 1) * 16 + swz / 64; C = (st & 1) * 32 + (swz % 64) / 2; }
__host__ __device__ __forceinline__ int perm32(int rho) { const int n = rho >> 4, i = rho & 15; return 8 * (i >> 2) + 4 * n + (i & 3); }

struct Unit { int pm, pn, e, ct, r0, n; };
struct Gemm { const bf16_t* A; const bf16_t* Bt; int K; };

struct StaticOrder {
    int nM, nN, nwg, G, c;
    __device__ void init(int M, int N, int G_, int c_) { nM = M / BM; nN = N / BM; nwg = nM * nN; G = G_; c = c_; }
    __device__ bool next(int i, Unit& u) const {
        const long L = (long)i * G + c; if (L >= nwg) return false;
        int wgid = (int)L; { const int q = nwg / NXCD, r = nwg % NXCD, xcd = wgid % NXCD, off = wgid / NXCD; wgid = (xcd < r ? xcd * (q + 1) : r * (q + 1) + (xcd - r) * q) + off; }
        const int nig = WGM * nN, gid = wgid / nig, fm = gid * WGM, gsz = (nM - fm) < WGM ? (nM - fm) : WGM;
        u.pm = fm + ((wgid % nig) % gsz); u.pn = (wgid % nig) / gsz; u.e = 0; u.ct = u.pn; u.r0 = 0; u.n = 0; return true;
    }
    __device__ __forceinline__ int arow(const Unit&, int) const { return 0; }
};
struct MoeOrder {
    const LAS int* tb; const int* rowtok; int ncol, G, c;
    __device__ bool next(int i, Unit& u) const {
        const int L = i * G + c; if (L >= tb[16] * ncol) return false;
        const int rt = L / ncol, ct = L - rt * ncol; int e = 0;
        while (tb[e + 1] <= rt) ++e;
        u.e = e; u.ct = ct; u.pm = rt; u.pn = e * ncol + ct; u.r0 = (rt - tb[e]) * 256; u.n = tb[17 + e]; return true;
    }
    __device__ __forceinline__ int arow(const Unit& u, int r) const { const int lr = u.r0 + r; return lr < u.n ? (rowtok[u.e * T + lr] & 0x7fffffff) : 0; }
};

__device__ __forceinline__ unsigned cvt_pk_bf16(float lo, float hi) { unsigned r; asm volatile("v_cvt_pk_bf16_f32 %0, %1, %2" : "=v"(r) : "v"(lo), "v"(hi)); return r; }

struct EpiProj {
    static constexpr bool PERM = true;
    bf16_t* P; float* LF; const float* lb;
    __device__ __forceinline__ void operator()(const f32x4 (&acc)[2][2][4][2], const Unit& u, int wr, int wc, int fr, int fq) const {
        const int row0 = u.pm * BM + wr * 64 + fr, colt = u.pn * BM, type = colt >> 10, col0 = colt + wc * 32 + 8 * fq;
#pragma unroll
        for (int ai = 0; ai < 2; ++ai)
#pragma unroll
            for (int m = 0; m < 4; ++m) { const int row = row0 + ai * HALF + m * 16; bf16_t* rowp = P + (size_t)row * INC + col0;
#pragma unroll
                for (int bj = 0; bj < 2; ++bj) { f32x4 v0 = acc[ai][bj][m][0], v1 = acc[ai][bj][m][1];
                    if (type == 0) { v0 = v0 * QSCALE; v1 = v1 * QSCALE; }
                    else if (type == 4) { const int ci = col0 + bj * HALF - C_FH; const f32x4 l0 = *(const f32x4*)(lb + ci), l1 = *(const f32x4*)(lb + ci + 4); f32x4 g0, g1;
#pragma unroll
                        for (int j = 0; j < 4; ++j) { float lf, kk; hgrn_gate(v0[j], l0[j], lf, kk); g0[j] = lf; v0[j] = kk; hgrn_gate(v1[j], l1[j], lf, kk); g1[j] = lf; v1[j] = kk; }
                        float* lfp = LF + (size_t)row * 1024 + ci; *(f32x4*)lfp = g0; *(f32x4*)(lfp + 4) = g1; }
                    else if (type == 6) {
#pragma unroll
                        for (int j = 0; j < 4; ++j) { v0[j] = siluf_(v0[j]); v1[j] = siluf_(v1[j]); } }
                    u32x4 w; w.x = cvt_pk_bf16(v0[0], v0[1]); w.y = cvt_pk_bf16(v0[2], v0[3]); w.z = cvt_pk_bf16(v1[0], v1[1]); w.w = cvt_pk_bf16(v1[2], v1[3]);
                    *(u32x4*)(rowp + bj * HALF) = w; } }
    }
};
struct EpiResid {
    static constexpr bool PERM = false;
    float* X; const float* gate;
    __device__ __forceinline__ void operator()(const f32x4 (&acc)[2][2][4][2], const Unit& u, int wr, int wc, int fr, int fq) const {
        const int row0 = u.pm * BM + wr * 64 + fr, col0 = u.pn * BM + wc * 32 + 4 * fq; const int b = (u.pm * BM) / S;
        f32x4 gv[2][2];
#pragma unroll
        for (int bj = 0; bj < 2; ++bj)
#pragma unroll
            for (int n = 0; n < 2; ++n) gv[bj][n] = *(const f32x4*)(gate + b * MODW + col0 + bj * HALF + n * 16);
#pragma unroll
        for (int ai = 0; ai < 2; ++ai)
#pragma unroll
            for (int m = 0; m < 4; ++m) { float* rowp = X + (size_t)(row0 + ai * HALF + m * 16) * D + col0;
#pragma unroll
                for (int bj = 0; bj < 2; ++bj)
#pragma unroll
                    for (int n = 0; n < 2; ++n) { f32x4* p = (f32x4*)(rowp + bj * HALF + n * 16); *p = *p + gv[bj][n] * acc[ai][bj][m][n]; } }
    }
};
struct EpiMoeUp {
    static constexpr bool PERM = true;
    bf16_t* act; const float* roww;
    __device__ __forceinline__ void operator()(const f32x4 (&acc)[2][2][4][2], const Unit& u, int wr, int wc, int fr, int fq) const {
        const int col0 = u.ct * 128 + wc * 32 + 8 * fq;
#pragma unroll
        for (int ai = 0; ai < 2; ++ai)
#pragma unroll
            for (int m = 0; m < 4; ++m) { const int r = ai * HALF + wr * 64 + m * 16 + fr, lr = u.r0 + r;
                if (lr < u.n) { const float w = roww[u.e * T + lr]; const f32x4 g0 = acc[ai][0][m][0], g1 = acc[ai][0][m][1], u0 = acc[ai][1][m][0], u1 = acc[ai][1][m][1]; f32x4 a0, a1;
#pragma unroll
                    for (int j = 0; j < 4; ++j) { a0[j] = siluf_(g0[j]) * u0[j] * w; a1[j] = siluf_(g1[j]) * u1[j] * w; }
                    u32x4 o; o.x = cvt_pk_bf16(a0[0], a0[1]); o.y = cvt_pk_bf16(a0[2], a0[3]); o.z = cvt_pk_bf16(a1[0], a1[1]); o.w = cvt_pk_bf16(a1[2], a1[3]);
                    *(u32x4*)(act + (size_t)(u.pm * BM + r) * DE + col0) = o; } }
    }
};
struct EpiMoeDown {
    static constexpr bool PERM = false;
    float* X; bf16_t* Y1; const float* gate; const int* rowtok;
    __device__ __forceinline__ void operator()(const f32x4 (&acc)[2][2][4][2], const Unit& u, int wr, int wc, int fr, int fq) const {
        const int col0 = u.ct * BM + wc * 32 + 4 * fq;
#pragma unroll
        for (int ai = 0; ai < 2; ++ai)
#pragma unroll
            for (int m = 0; m < 4; ++m) { const int lr = u.r0 + ai * HALF + wr * 64 + m * 16 + fr;
                if (lr < u.n) { const int ts = rowtok[u.e * T + lr], tok = ts & 0x7fffffff; const float* gp = gate + (tok / S) * MODW + col0;
                    if (ts >= 0) { float* rowp = X + (size_t)tok * D + col0;
#pragma unroll
                        for (int bj = 0; bj < 2; ++bj)
#pragma unroll
                            for (int n = 0; n < 2; ++n) { f32x4* p = (f32x4*)(rowp + bj * HALF + n * 16); *p = *p + *(const f32x4*)(gp + bj * HALF + n * 16) * acc[ai][bj][m][n]; } }
                    else { bf16_t* rowp = Y1 + (size_t)tok * D + col0;
#pragma unroll
                        for (int bj = 0; bj < 2; ++bj)
#pragma unroll
                            for (int n = 0; n < 2; ++n) { const f32x4 v = *(const f32x4*)(gp + bj * HALF + n * 16) * acc[ai][bj][m][n]; u32x2 o; o.x = cvt_pk_bf16(v[0], v[1]); o.y = cvt_pk_bf16(v[2], v[3]);
                                *(u32x2*)(rowp + bj * HALF + n * 16) = o; } } } }
    }
};

template <class Epi, class Sched, bool GATHER = false>
__device__ __forceinline__ void gemm_phase(LAS unsigned char* lds, const Gemm g, const Sched& S, const Epi& E) {
    int tid_ = threadIdx.x; asm volatile("" : "+v"(tid_));
    const int tid = tid_, wid = __builtin_amdgcn_readfirstlane(tid >> 6), lane = tid & 63, wr = wid >> 2, wc = wid & 3, fr = lane & 15, fq = lane >> 4;
    const int K = g.K, nt = K / BK;
    unsigned voffA[2], voffB[2]; int RA[2], CA[2];
#pragma unroll
    for (int i = 0; i < 2; ++i) { int R, C; stage_rc(tid * 16 + i * 8192, R, C); const int Rb = Epi::PERM ? ((R & ~31) + perm32(R & 31)) : R;
        voffA[i] = (unsigned)(R * K + C) * 2u; voffB[i] = (unsigned)(Rb * K + C) * 2u; RA[i] = R; CA[i] = C; }
    const size_t kstep = (size_t)(BK * 2);
    const size_t hstep = (size_t)HALF * K * 2;
    const size_t tstep = 2 * hstep;
    const unsigned ldsw = (unsigned)wid * 1024u;
    const int aoff = lds_byte(wr * 64 + fr, fq * 8), boff = lds_byte(wc * 32 + fr, fq * 8);
#define PG8_SA(b, h) (((b) * 2 + (h)) * HTB)
#define PG8_SB(b, h) ((4 + (b) * 2 + (h)) * HTB)
#define PG8_STAGE(bufoff, gbase, voff) do { _Pragma("unroll") for (int _i = 0; _i < 2; ++_i) \
        __builtin_amdgcn_global_load_lds((const unsigned*)((const char*)(gbase) + (voff)[_i]), (LAS unsigned*)(lds + (bufoff) + ldsw + _i * 8192), 16, 0, 0); } while (0)
#define PG8_STAGE_A(b, h, base, GO) do { if constexpr (GATHER) { PG8_STAGE(PG8_SA(b, h), base, GO[h]); } else { PG8_STAGE(PG8_SA(b, h), (base) + (h) * hstep, voffA); } } while (0)
#define PG8_GSET(GO, U) do { if constexpr (GATHER) { _Pragma("unroll") for (int _h = 0; _h < 2; ++_h) _Pragma("unroll") for (int _i = 0; _i < 2; ++_i) \
        GO[_h][_i] = (unsigned)(S.arow(U, _h * HALF + RA[_i]) * K + CA[_i]) * 2u; } } while (0)
#define PG8_LDA(dst, b, h) do { _Pragma("unroll") for (int m = 0; m < 4; ++m) _Pragma("unroll") for (int k = 0; k < 2; ++k) dst[m][k] = *(const LAS bf16x8*)(lds + PG8_SA(b, h) + aoff + m * 2048 + k * 1024); } while (0)
#define PG8_LDB(dst, b, h) do { _Pragma("unroll") for (int n = 0; n < 2; ++n) _Pragma("unroll") for (int k = 0; k < 2; ++k) dst[n][k] = *(const LAS bf16x8*)(lds + PG8_SB(b, h) + boff + n * 2048 + k * 1024); } while (0)
#define PG8_MMA(ai, bj, At, Bt) do { __builtin_amdgcn_s_setprio(1); _Pragma("unroll") for (int m = 0; m < 4; ++m) _Pragma("unroll") for (int n = 0; n < 2; ++n) _Pragma("unroll") for (int k = 0; k < 2; ++k) \
        acc[ai][bj][m][n] = __builtin_amdgcn_mfma_f32_16x16x32_bf16(Bt[n][k], At[m][k], acc[ai][bj][m][n], 0, 0, 0); __builtin_amdgcn_s_setprio(0); } while (0)
#define PG8_WAIT_V(n) asm volatile("s_waitcnt vmcnt(" #n ")" ::: "memory")
#define PG8_WAIT_L(n) asm volatile("s_waitcnt lgkmcnt(" #n ")" ::: "memory")
#define PG8_BAR __builtin_amdgcn_s_barrier()
#define PG8_SCHED __builtin_amdgcn_sched_barrier(0)
    Unit cur, nxt; int ui = 0;
    if (!S.next(0, cur)) return;
    f32x4 acc[2][2][4][2];
#pragma unroll
    for (int a = 0; a < 2; ++a)
#pragma unroll
        for (int b = 0; b < 2; ++b)
#pragma unroll
            for (int m = 0; m < 4; ++m)
#pragma unroll
                for (int n = 0; n < 2; ++n) acc[a][b][m][n] = (f32x4){0.f, 0.f, 0.f, 0.f};
    bf16x8 At[4][2], B0[2][2], B1[2][2];
    unsigned gcur[2][2] = {{0u, 0u}, {0u, 0u}}, gnxt[2][2] = {{0u, 0u}, {0u, 0u}}, gsel[2][2] = {{0u, 0u}, {0u, 0u}};
    const char* cA = GATHER ? (const char*)g.A : (const char*)g.A + (size_t)cur.pm * tstep; const char* cB = (const char*)g.Bt + (size_t)cur.pn * tstep;
    PG8_GSET(gcur, cur);
    PG8_STAGE(PG8_SB(0, 0), cB, voffB); PG8_STAGE(PG8_SB(0, 1), cB + hstep, voffB); PG8_STAGE_A(0, 0, cA, gcur); PG8_STAGE_A(0, 1, cA, gcur);
    if (wr == 1) PG8_BAR;
    PG8_WAIT_V(2); PG8_BAR;
    PG8_STAGE(PG8_SB(1, 0), cB + kstep, voffB); PG8_STAGE_A(1, 0, cA + kstep, gcur); PG8_STAGE(PG8_SB(1, 1), cB + hstep + kstep, voffB);
    PG8_WAIT_V(6); PG8_BAR;
    for (;;) {
        const bool has_next = S.next(ui + 1, nxt);
        const char* nA = GATHER ? (const char*)g.A : (has_next ? (const char*)g.A + (size_t)nxt.pm * tstep : cA); const char* nB = has_next ? (const char*)g.Bt + (size_t)nxt.pn * tstep : cB;
        if constexpr (GATHER) { if (has_next) { PG8_GSET(gnxt, nxt); } else {
#pragma unroll
            for (int h = 0; h < 2; ++h)
#pragma unroll
                for (int i = 0; i < 2; ++i) gnxt[h][i] = gcur[h][i]; } }
        for (int t = 0; t < nt; t += 2) {
            const bool last = (t == nt - 2);
            const char* a1 = cA + (size_t)(t + 1) * kstep;
            const char* a2 = last ? nA : cA + (size_t)(t + 2) * kstep; const char* b2 = last ? nB : cB + (size_t)(t + 2) * kstep;
            const char* a3 = a2 + kstep; const char* b3 = b2 + kstep;
            if constexpr (GATHER) {
#pragma unroll
                for (int h = 0; h < 2; ++h)
#pragma unroll
                    for (int i = 0; i < 2; ++i) gsel[h][i] = last ? gnxt[h][i] : gcur[h][i]; }
            PG8_LDB(B0, 0, 0); PG8_LDB(B1, 0, 1); PG8_SCHED; PG8_LDA(At, 0, 0); PG8_STAGE_A(1, 1, a1, gcur);
            PG8_WAIT_V(8); PG8_WAIT_L(0); PG8_BAR; PG8_MMA(0, 0, At, B0); PG8_MMA(0, 1, At, B1); PG8_BAR; PG8_SCHED;
            PG8_LDA(At, 0, 1); PG8_STAGE(PG8_SB(0, 0), b2, voffB); PG8_STAGE(PG8_SB(0, 1), b2 + hstep, voffB); PG8_STAGE_A(0, 0, a2, gsel);
            PG8_WAIT_V(8); PG8_WAIT_L(0); PG8_BAR; PG8_MMA(1, 0, At, B0); PG8_MMA(1, 1, At, B1); PG8_BAR; PG8_SCHED;
            PG8_LDB(B0, 1, 0); PG8_LDB(B1, 1, 1); PG8_SCHED; PG8_LDA(At, 1, 0); PG8_STAGE_A(0, 1, a2, gsel);
            PG8_WAIT_V(8); PG8_WAIT_L(0); PG8_BAR; PG8_MMA(0, 0, At, B0); PG8_MMA(0, 1, At, B1); PG8_BAR; PG8_SCHED;
            PG8_LDA(At, 1, 1); PG8_STAGE(PG8_SB(1, 0), b3, voffB); PG8_STAGE(PG8_SB(1, 1), b3 + hstep, voffB); PG8_STAGE_A(1, 0, a3, gsel);
            PG8_WAIT_V(8); PG8_WAIT_L(0); PG8_BAR; PG8_MMA(1, 0, At, B0); PG8_MMA(1, 1, At, B1); PG8_BAR; PG8_SCHED;
        }
        if (wr == 0) PG8_BAR;
        E(acc, cur, wr, wc, fr, fq);
        if (!has_next) break;
#pragma unroll
        for (int a = 0; a < 2; ++a)
#pragma unroll
            for (int b = 0; b < 2; ++b)
#pragma unroll
                for (int m = 0; m < 4; ++m)
#pragma unroll
                    for (int n = 0; n < 2; ++n) acc[a][b][m][n] = (f32x4){0.f, 0.f, 0.f, 0.f};
        cur = nxt; cA = nA; cB = nB; ++ui;
        if constexpr (GATHER) {
#pragma unroll
            for (int h = 0; h < 2; ++h)
#pragma unroll
                for (int i = 0; i < 2; ++i) gcur[h][i] = gnxt[h][i]; }
        if (wr == 1) PG8_BAR;
    }
    PG8_WAIT_V(0);
    PG8_BAR;
#undef PG8_SA
#undef PG8_SB
#undef PG8_STAGE
#undef PG8_STAGE_A
#undef PG8_GSET
#undef PG8_LDA
#undef PG8_LDB
#undef PG8_MMA
#undef PG8_WAIT_V
#undef PG8_WAIT_L
#undef PG8_BAR
#undef PG8_SCHED
}
}
namespace att {
typedef short s16x4 __attribute__((ext_vector_type(4)));
constexpr int KVBLK = 64, SHM_V = KVBLK * 128 * 2, SHM_K = KVBLK * 128 * 2;
constexpr int OFF_V = 0, OFF_K = 2 * SHM_V, OFF_WS = OFF_K + 2 * SHM_K, OFF_BL = OFF_WS + 8 * 64 * 4, LDS_ATT = OFF_BL + 2 * 128 * 4;
constexpr float THR = 8.f;
#define AT_KSWZ(row, colB) ((row) * 256 + ((colB) ^ (((row) & 15) << 4)))
#define AT_SBAR() __builtin_amdgcn_sched_barrier(0)
__device__ __forceinline__ int crow(int r, int hi) { return (r & 3) + 8 * (r >> 2) + 4 * hi; }
__device__ __forceinline__ unsigned cvtpk(float lo, float hi) { unsigned r; asm volatile("v_cvt_pk_bf16_f32 %0, %1, %2" : "=v"(r) : "v"(lo), "v"(hi)); return r; }

__device__ __forceinline__ void partialSM(f32x16& p0, f32x16& p1, float& m_reg, float& alpha) {
    float pmax = p0[0];
#pragma unroll
    for (int r = 1; r < 16; ++r) pmax = fmaxf(pmax, p0[r]);
#pragma unroll
    for (int r = 0; r < 16; ++r) pmax = fmaxf(pmax, p1[r]);
    { auto rr = __builtin_amdgcn_permlane32_swap(__float_as_uint(pmax), __float_as_uint(pmax), false, false); pmax = fmaxf(__uint_as_float(rr[0]), __uint_as_float(rr[1])); }
    float mn;
    if (__builtin_expect(__all(pmax - m_reg <= THR), 1)) { mn = m_reg; alpha = 1.f; }
    else { mn = fmaxf(m_reg, pmax); alpha = __builtin_amdgcn_exp2f(m_reg - mn); m_reg = mn; }
#pragma unroll
    for (int r = 0; r < 16; ++r) { p0[r] -= mn; p1[r] -= mn; }
#pragma unroll
    for (int r = 0; r < 16; ++r) p0[r] = __builtin_amdgcn_exp2f(p0[r]);
}
__device__ __forceinline__ void finishSM(f32x16& p0, f32x16& p1, float alpha, float& l_reg, bf16x8& pa0, bf16x8& pa1, bf16x8& pa2, bf16x8& pa3) {
#pragma unroll
    for (int r = 0; r < 16; ++r) p1[r] = __builtin_amdgcn_exp2f(p1[r]);
    float ps = 0.f;
#pragma unroll
    for (int r = 0; r < 16; ++r) ps += p0[r];
#pragma unroll
    for (int r = 0; r < 16; ++r) ps += p1[r];
    { auto rr = __builtin_amdgcn_permlane32_swap(__float_as_uint(ps), __float_as_uint(ps), false, false); ps = __uint_as_float(rr[0]) + __uint_as_float(rr[1]); }
    l_reg = l_reg * alpha + ps;
#define AT_PK4(Pv, BASE, OUT) do { unsigned a0 = cvtpk(Pv[BASE + 0], Pv[BASE + 1]), a1 = cvtpk(Pv[BASE + 2], Pv[BASE + 3]);   \
    unsigned b0 = cvtpk(Pv[BASE + 4], Pv[BASE + 5]), b1 = cvtpk(Pv[BASE + 6], Pv[BASE + 7]);                              \
    auto r0 = __builtin_amdgcn_permlane32_swap(a0, b0, false, false); auto r1 = __builtin_amdgcn_permlane32_swap(a1, b1, false, false); \
    u32x4 w = {r0[0], r1[0], r0[1], r1[1]}; OUT = __builtin_bit_cast(bf16x8, w); } while (0)
    AT_PK4(p0, 0, pa0); AT_PK4(p0, 8, pa1); AT_PK4(p1, 0, pa2); AT_PK4(p1, 8, pa3);
#undef AT_PK4
}
__device__ __forceinline__ void qkt(f32x16& p0, f32x16& p1, const LAS char* Ks, const bf16x8* qr, int kb) {
    p0 = f32x16{}; p1 = f32x16{};
#pragma unroll
    for (int d0 = 0; d0 < 4; ++d0) {
        const bf16x8 b0 = *(const LAS bf16x8*)(Ks + (kb ^ (d0 * 32)));
        const bf16x8 b1 = *(const LAS bf16x8*)(Ks + 32 * 256 + (kb ^ (d0 * 32)));
        p0 = __builtin_amdgcn_mfma_f32_32x32x16_bf16(b0, qr[d0], p0, 0, 0, 0);
        p1 = __builtin_amdgcn_mfma_f32_32x32x16_bf16(b1, qr[d0], p1, 0, 0, 0); }
}
__device__ __forceinline__ void adj(f32x16& p0, f32x16& p1, int q, int k0, int hi, const LAS float* bl) {
#pragma unroll
    for (int r = 0; r < 16; ++r) { const int rel0 = q - (k0 + crow(r, hi)), rel1 = rel0 - 32;
        const float b0 = bl[min(max(rel0, 0), 127)], b1 = bl[min(max(rel1, 0), 127)];
        p0[r] = rel0 >= 0 ? p0[r] + b0 : -1e30f; p1[r] = rel1 >= 0 ? p1[r] + b1 : -1e30f; }
}
__device__ __forceinline__ int v_st(int k, int c) { const int kk = (k & ~0xC) | ((k & 4) << 1) | ((k & 8) >> 1); return ((kk >> 3) * 4 + (c >> 5)) * 512 + ((kk & 7) * 32 + (c & 31)) * 2; }
__device__ __forceinline__ int v_rd_base(int lane) { return ((lane & 3) << 3) | (((lane >> 2) & 3) << 6) | (((lane >> 4) & 1) << 5) | (((lane >> 5) & 1) << 8); }
constexpr int v_rd_off(int d0, int ks, int half) { return d0 * 512 + ks * 4096 + half * 2048; }
template <int OFF> __device__ __forceinline__ s16x4 tr_read(int vb) { s16x4 r; asm volatile("ds_read_b64_tr_b16 %0, %1 offset:%2" : "=&v"(r) : "v"(vb), "i"(OFF) : "memory"); return r; }
template <int D0> __device__ __forceinline__ void pv_one(f32x16& od, int vb, bf16x8 pa0, bf16x8 pa1, bf16x8 pa2, bf16x8 pa3) {
    const s16x4 l0 = tr_read<v_rd_off(D0, 0, 0)>(vb), h0 = tr_read<v_rd_off(D0, 0, 1)>(vb), l1 = tr_read<v_rd_off(D0, 1, 0)>(vb), h1 = tr_read<v_rd_off(D0, 1, 1)>(vb);
    const s16x4 l2 = tr_read<v_rd_off(D0, 2, 0)>(vb), h2 = tr_read<v_rd_off(D0, 2, 1)>(vb), l3 = tr_read<v_rd_off(D0, 3, 0)>(vb), h3 = tr_read<v_rd_off(D0, 3, 1)>(vb);
    asm volatile("s_waitcnt lgkmcnt(0)" ::: "memory"); AT_SBAR();
#define AT_PK(L, H) (bf16x8){L[0], L[1], L[2], L[3], H[0], H[1], H[2], H[3]}
    od = __builtin_amdgcn_mfma_f32_32x32x16_bf16(pa0, AT_PK(l0, h0), od, 0, 0, 0);
    od = __builtin_amdgcn_mfma_f32_32x32x16_bf16(pa1, AT_PK(l1, h1), od, 0, 0, 0);
    od = __builtin_amdgcn_mfma_f32_32x32x16_bf16(pa2, AT_PK(l2, h2), od, 0, 0, 0);
    od = __builtin_amdgcn_mfma_f32_32x32x16_bf16(pa3, AT_PK(l3, h3), od, 0, 0, 0);
#undef AT_PK
}
__device__ __forceinline__ void pv_d0(f32x16* o, int vb, bf16x8 pa0, bf16x8 pa1, bf16x8 pa2, bf16x8 pa3) {
    pv_one<0>(o[0], vb, pa0, pa1, pa2, pa3); pv_one<1>(o[1], vb, pa0, pa1, pa2, pa3); pv_one<2>(o[2], vb, pa0, pa1, pa2, pa3); pv_one<3>(o[3], vb, pa0, pa1, pa2, pa3);
}

__device__ __forceinline__ void attn_unit(int b, int h, int qb, const bf16_t* __restrict__ P, bf16_t* MIX, const float* rel_bias, const float* subln, float lam, float osc, LAS char* lds, int tid) {
    const int wid = __builtin_amdgcn_readfirstlane(tid >> 6), lane = tid & 63, r32 = lane & 31, hi = lane >> 5, jm = wid >> 2, w4 = wid & 3;
    LAS char* V_lds = lds + OFF_V; LAS char* K_lds = lds + OFF_K;
    LAS float* wsf = (LAS float*)(lds + OFF_WS) + wid * 64; LAS float* li_l = wsf; LAS float* al_l = wsf + 32;
    LAS float* bl = (LAS float*)(lds + OFF_BL);
    const int q0 = qb * 128, qw = q0 + w4 * 32, qpos = qw + r32;
    const size_t rowb = (size_t)b * S;
    if (tid < 256) { const int j = tid >> 7, d = tid & 127; bl[tid] = (rel_bias[(int)T5B[d] * 16 + 2 * h + j] - rel_bias[31 * 16 + 2 * h + j]) * LOG2E; }
    float m_reg = -1e30f, l_reg = 0.f; f32x16 o[4] = {}; bf16x8 qr[4];
    { const bf16_t* Qw = P + (rowb + qpos) * INC + C_QD + h * 128 + jm * 64 + hi * 8;
#pragma unroll
      for (int d0 = 0; d0 < 4; ++d0) qr[d0] = *(const bf16x8*)(Qw + d0 * 16); }
    const __amdgpu_buffer_rsrc_t rs = __builtin_amdgcn_make_buffer_rsrc((void*)((const char*)P + (rowb * INC + C_KD + h * 128) * 2), 0, (int)((size_t)S * INC * 2), 0x00020000);
    const int sr = tid >> 4, sc = (tid & 15) * 8, vst0 = v_st(sr, sc), vst1 = v_st(32 + sr, sc);
    const unsigned voff = (unsigned)(sr * INC + sc) * 2u;
    const int kst0 = AT_KSWZ(sr, sc * 2), kst1 = AT_KSWZ(32 + sr, sc * 2);
    const int vb0 = (int)(uintptr_t)V_lds + v_rd_base(lane);
    const int kb = AT_KSWZ(r32, jm * 128 + hi * 16);
    const LAS float* blj = bl + jm * 128;
    struct { bf16x8 vs0, vs1, ks0, ks1; } sr_[2];
#define AT_BL(so) __builtin_bit_cast(bf16x8, __builtin_amdgcn_raw_buffer_load_b128(rs, voff, (so), 0))
#define AT_SLOAD(i, k0) do { const int so_ = (k0) * (INC * 2); \
    sr_[i].vs0 = AT_BL(so_ + (C_VD - C_KD) * 2); sr_[i].vs1 = AT_BL(so_ + (C_VD - C_KD) * 2 + 32 * INC * 2); \
    sr_[i].ks0 = AT_BL(so_); sr_[i].ks1 = AT_BL(so_ + 32 * INC * 2); } while (0)
#define AT_SWRITE(bf, i) do { *(LAS bf16x8*)(V_lds + (bf) * SHM_V + vst0) = sr_[i].vs0; *(LAS bf16x8*)(V_lds + (bf) * SHM_V + vst1) = sr_[i].vs1; \
    *(LAS bf16x8*)(K_lds + (bf) * SHM_K + kst0) = sr_[i].ks0; *(LAS bf16x8*)(K_lds + (bf) * SHM_K + kst1) = sr_[i].ks1; } while (0)
#define AT_SWAIT() asm volatile("s_waitcnt vmcnt(4)" ::: "memory")
#define AT_RESC(a) do { if (__any((a) < 1.f)) { if (hi == 0) al_l[r32] = (a); asm volatile("s_waitcnt lgkmcnt(0)" ::: "memory"); \
    _Pragma("unroll") for (int d = 0; d < 4; ++d) _Pragma("unroll") for (int r = 0; r < 16; ++r) o[d][r] *= al_l[crow(r, hi)]; } } while (0)
#define AT_ADJ(PA, PB, t) do { const int k0_ = (t) * KVBLK; if (qw - (k0_ + 63) < 113) adj(PA, PB, qpos, k0_, hi, blj); } while (0)
    f32x16 pA0, pA1, pB0, pB1; float alA, alB; bf16x8 pa0, pa1, pa2, pa3; const int NT = 2 * qb + 2;
    AT_SLOAD(0, 0); asm volatile("s_waitcnt vmcnt(0)" ::: "memory"); AT_SWRITE(0, 0); __syncthreads();
    qkt(pA0, pA1, K_lds, qr, kb); AT_ADJ(pA0, pA1, 0); partialSM(pA0, pA1, m_reg, alA);
    AT_SLOAD(1, KVBLK); if (2 < NT) AT_SLOAD(0, 2 * KVBLK);
    AT_SWAIT(); AT_SWRITE(1, 1); __syncthreads();
    for (int j = 1; j + 1 < NT; j += 2) {
        AT_SBAR(); qkt(pB0, pB1, K_lds + SHM_K, qr, kb);
        finishSM(pA0, pA1, alA, l_reg, pa0, pa1, pa2, pa3); AT_SBAR();
        AT_SLOAD(1, (j + 2) * KVBLK); AT_SBAR();
        pv_d0(o, vb0, pa0, pa1, pa2, pa3); AT_ADJ(pB0, pB1, j); partialSM(pB0, pB1, m_reg, alB);
        __syncthreads(); AT_SWAIT(); AT_SWRITE(0, 0);
        AT_RESC(alB); __syncthreads();
        AT_SBAR(); qkt(pA0, pA1, K_lds, qr, kb);
        finishSM(pB0, pB1, alB, l_reg, pa0, pa1, pa2, pa3); AT_SBAR();
        if (j + 3 < NT) AT_SLOAD(0, (j + 3) * KVBLK); AT_SBAR();
        pv_d0(o, vb0 + SHM_V, pa0, pa1, pa2, pa3); AT_ADJ(pA0, pA1, j + 1); partialSM(pA0, pA1, m_reg, alA);
        __syncthreads(); AT_SWAIT(); AT_SWRITE(1, 1);
        AT_RESC(alA); __syncthreads();
    }
    AT_SBAR(); qkt(pB0, pB1, K_lds + SHM_K, qr, kb);
    finishSM(pA0, pA1, alA, l_reg, pa0, pa1, pa2, pa3); AT_SBAR();
    pv_d0(o, vb0, pa0, pa1, pa2, pa3); AT_ADJ(pB0, pB1, NT - 1); partialSM(pB0, pB1, m_reg, alB);
    __syncthreads(); AT_RESC(alB);
    finishSM(pB0, pB1, alB, l_reg, pa0, pa1, pa2, pa3); AT_SBAR();
    pv_d0(o, vb0 + SHM_V, pa0, pa1, pa2, pa3);
    int t2 = tid; asm volatile("" : "+v"(t2));
    const int lane2 = t2 & 63, r32b = lane2 & 31, hib = lane2 >> 5;
    if (hib == 0) li_l[r32b] = l_reg; asm volatile("s_waitcnt lgkmcnt(0)" ::: "memory");
    float rli[16];
#pragma unroll
    for (int r = 0; r < 16; ++r) rli[r] = __builtin_amdgcn_rcpf(li_l[crow(r, hib)]);
    __syncthreads();
    LAS float* xch = (LAS float*)lds + (w4 * 64) * 64 + lane2;
    if (jm == 1) {
#pragma unroll
        for (int d0 = 0; d0 < 4; ++d0)
#pragma unroll
            for (int r = 0; r < 16; ++r) xch[(d0 * 16 + r) * 64] = o[d0][r] * rli[r] * lam; }
    __syncthreads();
    if (jm == 0) {
#pragma unroll
        for (int r = 0; r < 16; ++r) { float a = 0.f;
#pragma unroll
            for (int d0 = 0; d0 < 4; ++d0) { const float dv = o[d0][r] * rli[r] - xch[(d0 * 16 + r) * 64]; o[d0][r] = dv; a += dv * dv; }
#pragma unroll
            for (int m = 1; m < 32; m <<= 1) a += __shfl_xor(a, m);
            rli[r] = rsqrtf(a * (1.f / 128.f) + EPS) * osc; }
        float sg[4];
#pragma unroll
        for (int d0 = 0; d0 < 4; ++d0) sg[d0] = subln[32 * d0 + r32b];
        bf16_t* Ow = MIX + (rowb + qw) * D + h * 128 + r32b;
#pragma unroll
        for (int r = 0; r < 16; ++r) { const int orow = crow(r, hib);
#pragma unroll
            for (int d0 = 0; d0 < 4; ++d0) Ow[(size_t)orow * D + d0 * 32] = (bf16_t)f2bf(o[d0][r] * rli[r] * sg[d0]); }
    }
    __syncthreads();
#undef AT_SLOAD
#undef AT_BL
#undef AT_SWRITE
#undef AT_SWAIT
#undef AT_RESC
#undef AT_ADJ
}
#undef AT_KSWZ
#undef AT_SBAR
}

namespace hg {
__device__ __forceinline__ int sw128(int r, int c) { return r * 128 + (((c ^ (r >> 1)) & 7) << 4); }
__device__ __forceinline__ int sw256(int r, int c) { return r * 256 + (((c ^ r) & 15) << 4); }
constexpr int OFF_QT = 0, OFF_VT = 2048, OFF_KE = OFF_VT + 16384;
constexpr int OFF_QS = OFF_KE, OFF_QM = OFF_QS + 16384, OFF_KM = OFF_QM + 16384, OFF_AB = OFF_KM + 16384, OFF_OX = OFF_AB + 8192;
constexpr int OXS = 132;
__device__ __forceinline__ int crow(int r, int hi) { return (r & 3) + 8 * (r >> 2) + 4 * hi; }

__device__ __forceinline__ void cumsum_b(const float* LFp, size_t row0, int h, int d, int tq, LAS float* qt, float (&bq)[16], float& bend, float& bmid) {
    float run = 0.f; const float* p = LFp + (row0 + 16 * tq) * 1024 + h * 128 + d;
#pragma unroll
    for (int i = 0; i < 16; ++i) { run += p[(size_t)i * 1024]; bq[i] = run; }
    qt[tq * 128 + d] = run;
    __syncthreads();
    const float q0 = qt[d], q1 = qt[128 + d], q2 = qt[256 + d], q3 = qt[384 + d];
    const float off = tq == 0 ? 0.f : tq == 1 ? q0 : tq == 2 ? q0 + q1 : q0 + q1 + q2;
#pragma unroll
    for (int i = 0; i < 16; ++i) bq[i] += off;
    bend = (q0 + q1) + (q2 + q3); bmid = q0 + q1;
}
__device__ __forceinline__ void hg1_unit(int bh, int c, const bf16_t* __restrict__ Pp, const float* __restrict__ LFp, float* KV, float* DEC, LAS char* lds, int tid) {
    const int d = tid & 127, tq = tid >> 7, h = bh & 7, wid = __builtin_amdgcn_readfirstlane(tid >> 6), lane = tid & 63, r = lane & 31, hh = lane >> 5;
    const size_t row0 = (size_t)(bh >> 3) * S + c * 64;
    float bq[16], bend, bmid;
    cumsum_b(LFp, row0, h, d, tq, (LAS float*)(lds + OFF_QT), bq, bend, bmid);
    { const bf16_t* kp = Pp + (row0 + 16 * tq) * INC + C_FH + h * 128 + d; const bf16_t* vp = Pp + (row0 + 16 * tq) * INC + C_IH + h * 128 + d;
      unsigned kw[8], vw[8];
#pragma unroll
      for (int i = 0; i < 8; ++i) { const float k0 = bf2f(kp[(size_t)(2 * i) * INC]) * __expf(bend - bq[2 * i]), k1 = bf2f(kp[(size_t)(2 * i + 1) * INC]) * __expf(bend - bq[2 * i + 1]);
          kw[i] = pk2(k0, k1); vw[i] = (unsigned)vp[(size_t)(2 * i) * INC] | ((unsigned)vp[(size_t)(2 * i + 1) * INC] << 16); }
      *(LAS u32x4*)(lds + OFF_KE + sw128(d, 2 * tq)) = (u32x4){kw[0], kw[1], kw[2], kw[3]}; *(LAS u32x4*)(lds + OFF_KE + sw128(d, 2 * tq + 1)) = (u32x4){kw[4], kw[5], kw[6], kw[7]};
      *(LAS u32x4*)(lds + OFF_VT + sw128(d, 2 * tq)) = (u32x4){vw[0], vw[1], vw[2], vw[3]}; *(LAS u32x4*)(lds + OFF_VT + sw128(d, 2 * tq + 1)) = (u32x4){vw[4], vw[5], vw[6], vw[7]}; }
    if (tq == 0) DEC[((size_t)bh * NCH + c) * 128 + d] = __expf(bend);
    __syncthreads();
    const int vbase = (wid & 3) * 32;
#pragma unroll
    for (int dt = 0; dt < 2; ++dt) { const int dbase = (wid >> 2) * 64 + dt * 32; f32x16 acc = {};
#pragma unroll
        for (int ks = 0; ks < 4; ++ks) { const bf16x8 a = *(const LAS bf16x8*)(lds + OFF_VT + sw128(vbase + r, 2 * ks + hh)), bb = *(const LAS bf16x8*)(lds + OFF_KE + sw128(dbase + r, 2 * ks + hh));
            acc = __builtin_amdgcn_mfma_f32_32x32x16_bf16(a, bb, acc, 0, 0, 0); }
        float* op = KV + (((size_t)bh * NCH + c) * 128 + vbase) * 128 + dbase + r;
#pragma unroll
        for (int q = 0; q < 16; ++q) op[(size_t)crow(q, hh) * 128] = acc[q]; }
    __syncthreads();
}
__device__ __forceinline__ void hg3_unit(int bh, int c, const bf16_t* __restrict__ Pp, const float* __restrict__ LFp, const bf16_t* __restrict__ ST, const float* hnorm, bf16_t* MIXp, LAS char* lds, int tid) {
    const int d = tid & 127, tq = tid >> 7, h = bh & 7, wid = __builtin_amdgcn_readfirstlane(tid >> 6), lane = tid & 63, r = lane & 31, hh = lane >> 5;
    const size_t row0 = (size_t)(bh >> 3) * S + c * 64;
    float bq[16], bend, bmid;
    cumsum_b(LFp, row0, h, d, tq, (LAS float*)(lds + OFF_QT), bq, bend, bmid);
    { const bf16_t* qp = Pp + (row0 + 16 * tq) * INC + C_QH + h * 128 + d; const bf16_t* kp = Pp + (row0 + 16 * tq) * INC + C_FH + h * 128 + d; const bf16_t* vp = Pp + (row0 + 16 * tq) * INC + C_IH + h * 128 + d;
      unsigned vw[8];
#pragma unroll
      for (int i = 0; i < 16; ++i) { const int t = 16 * tq + i; const float qv = bf2f(qp[(size_t)i * INC]), kv = bf2f(kp[(size_t)i * INC]); const float e1 = __expf(bq[i] - bmid);
          const int o256 = sw256(t, d >> 3) + (d & 7) * 2;
          *(LAS bf16_t*)(lds + OFF_QS + o256) = (bf16_t)f2bf(qv * __expf(bq[i]));
          *(LAS bf16_t*)(lds + OFF_QM + o256) = (bf16_t)f2bf(qv * e1);
          *(LAS bf16_t*)(lds + OFF_KM + o256) = (bf16_t)f2bf(kv * __builtin_amdgcn_rcpf(e1)); }
#pragma unroll
      for (int i = 0; i < 8; ++i) vw[i] = (unsigned)vp[(size_t)(2 * i) * INC] | ((unsigned)vp[(size_t)(2 * i + 1) * INC] << 16);
      *(LAS u32x4*)(lds + OFF_VT + sw128(d, 2 * tq)) = (u32x4){vw[0], vw[1], vw[2], vw[3]}; *(LAS u32x4*)(lds + OFF_VT + sw128(d, 2 * tq + 1)) = (u32x4){vw[4], vw[5], vw[6], vw[7]}; }
    __syncthreads();
    if (wid < 4) { const int ti = wid & 1, si = wid >> 1; f32x16 acc = {};
        if (!(ti == 0 && si == 1)) {
#pragma unroll
            for (int ks = 0; ks < 8; ++ks) { const bf16x8 a = *(const LAS bf16x8*)(lds + OFF_QM + sw256(ti * 32 + r, 2 * ks + hh)), bb = *(const LAS bf16x8*)(lds + OFF_KM + sw256(si * 32 + r, 2 * ks + hh));
                acc = __builtin_amdgcn_mfma_f32_32x32x16_bf16(a, bb, acc, 0, 0, 0); } }
        const int sidx = si * 32 + r;
#pragma unroll
        for (int q = 0; q < 16; ++q) { const int t = ti * 32 + crow(q, hh); const float v = (sidx <= t) ? acc[q] : 0.f;
            *(LAS bf16_t*)(lds + OFF_AB + sw128(t, sidx >> 3) + (sidx & 7) * 2) = (bf16_t)f2bf(v); } }
    __syncthreads();
    {
        const int tb = (wid & 1) * 32, vb = (wid >> 1) * 32; f32x16 acc = {};
        const bf16_t* sp = ST + (((size_t)bh * NCH + c) * 128 + vb + r) * 128 + 8 * hh;
        bf16x8 sf[8];
#pragma unroll
        for (int ks = 0; ks < 8; ++ks) sf[ks] = *(const bf16x8*)(sp + 16 * ks);
#pragma unroll
        for (int ks = 0; ks < 4; ++ks) { const bf16x8 a = *(const LAS bf16x8*)(lds + OFF_AB + sw128(tb + r, 2 * ks + hh)), bb = *(const LAS bf16x8*)(lds + OFF_VT + sw128(vb + r, 2 * ks + hh));
            acc = __builtin_amdgcn_mfma_f32_32x32x16_bf16(a, bb, acc, 0, 0, 0); }
#pragma unroll
        for (int ks = 0; ks < 8; ++ks) { const bf16x8 a = *(const LAS bf16x8*)(lds + OFF_QS + sw256(tb + r, 2 * ks + hh));
            acc = __builtin_amdgcn_mfma_f32_32x32x16_bf16(a, sf[ks], acc, 0, 0, 0); }
        LAS float* ox = (LAS float*)(lds + OFF_OX);
#pragma unroll
        for (int q = 0; q < 16; ++q) ox[(tb + crow(q, hh)) * OXS + vb + r] = acc[q]; }
    __syncthreads();
    {
        const int t = tid >> 3, part = tid & 7; const LAS float* ox = (const LAS float*)(lds + OFF_OX) + t * OXS + part * 16;
        f32x4 v[4]; float ss = 0.f;
#pragma unroll
        for (int i = 0; i < 4; ++i) { v[i] = *(const LAS f32x4*)(ox + 4 * i); ss += (v[i][0] * v[i][0] + v[i][1] * v[i][1]) + (v[i][2] * v[i][2] + v[i][3] * v[i][3]); }
        ss += __shfl_xor(ss, 1); ss += __shfl_xor(ss, 2); ss += __shfl_xor(ss, 4);
        const float rn = rsqrtf(ss * (1.f / 128.f) + EPS);
        const bf16_t* gp = Pp + (row0 + t) * INC + C_GH + h * 128 + part * 16; const u32x4 g0 = *(const u32x4*)gp, g1 = *(const u32x4*)(gp + 8);
        const float* hn = hnorm + part * 16; unsigned ow[8];
#pragma unroll
        for (int i = 0; i < 8; ++i) { const unsigned gw = i < 4 ? g0[i] : g1[i - 4]; const int e = 2 * i;
            ow[i] = pk2(v[e >> 2][e & 3] * rn * hn[e] * bflo(gw), v[(e + 1) >> 2][(e + 1) & 3] * rn * hn[e + 1] * bfhi(gw)); }
        bf16_t* op = MIXp + (row0 + t) * D + 1024 + h * 128 + part * 16;
        *(u32x4*)op = (u32x4){ow[0], ow[1], ow[2], ow[3]}; *(u32x4*)(op + 8) = (u32x4){ow[4], ow[5], ow[6], ow[7]}; }
    __syncthreads();
}
}

#define MIXER_PHASES \
        if (IN(PH_ATT)) { PHASE_LOCALS \
            const float lam = LAM[l]; const float osc = 1.f - (0.8f - 0.6f * expf(-0.3f * (float)l)); \
            for (int pr = wg; pr < 256; pr += G) { const int vcu = (pr & 7) * 32 + (pr >> 3), bh = vcu >> 4, s = vcu & 15; \
                _Pragma("unroll 1") for (int u2 = 0; u2 < 2; ++u2) \
                    att::attn_unit(bh >> 3, bh & 7, u2 ? s : 31 - s, P, MIX, args.in[15], args.in[12] + l * 128, lam, osc, (LAS char*)lds, tid); } \
            for (int u = wg; u < NB * 8 * NCH; u += G) hg::hg1_unit(u >> 6, u & 63, P, LF, (float*)(ws + WS_KV), (float*)(ws + WS_DEC), (LAS char*)lds, tid); \
            GRID_BAR(); } \
        if (IN(PH_SCAN)) { PHASE_LOCALS \
            const float* KV = (const float*)(ws + WS_KV); const float* DEC = (const float*)(ws + WS_DEC); bf16_t* ST = (bf16_t*)(ws + WS_ST); \
            for (int gid = wg * NTHR + tid; gid < NB * 8 * 8192; gid += G * NTHR) { const int bh = gid >> 13, f = (gid & 8191) * 2, dd = f & 127; float s0 = 0.f, s1 = 0.f; \
                _Pragma("unroll 8") for (int c = 0; c < NCH; ++c) { const size_t cb = (size_t)bh * NCH + c; const float2 kv = *(const float2*)(KV + cb * 16384 + f), dc = *(const float2*)(DEC + cb * 128 + dd); \
                    *(unsigned*)(ST + cb * 16384 + f) = pk2(s0, s1); s0 = dc.x * s0 + kv.x; s1 = dc.y * s1 + kv.y; } } \
            GRID_BAR(); } \
        if (IN(PH_HG3)) { PHASE_LOCALS \
            for (int u = wg; u < NB * 8 * NCH; u += G) hg::hg3_unit(u >> 6, u & 63, P, LF, (const bf16_t*)(ws + WS_ST), args.in[14] + l * 128, MIX, (LAS char*)lds, tid); \
            GRID_BAR(); }
constexpr int NWAVES = 8, NTHR = NWAVES * 64;
constexpr size_t MiB = 1u << 20;
constexpr size_t WS_CTL = 0, CTL_ZERO_BYTES = 1 * MiB;
constexpr size_t WS_MOD = 1 * MiB;
constexpr size_t WS_LB = WS_MOD + 512 * 1024;
constexpr size_t WS_LAM = WS_LB + 16 * 1024;
constexpr size_t WS_SEL = 2 * MiB;
constexpr size_t WS_SELPOS = WS_SEL + 64 * 1024, WS_ROWW = WS_SEL + 128 * 1024, WS_ROWTOK = WS_ROWW + 512 * 1024;
constexpr size_t WS_WIN = 4 * MiB;
constexpr size_t WS_WOUT = WS_WIN + (size_t)DEPTH * INC * D * 2;
constexpr size_t WS_WGU = WS_WOUT + (size_t)DEPTH * D * D * 2;
constexpr size_t WS_WD = WS_WGU + (size_t)DEPTH * NE * 1024 * D * 2;
constexpr size_t WS_X = WS_WD + (size_t)DEPTH * NE * D * DE * 2;
constexpr size_t WS_HB = WS_X + (size_t)T * D * 4;
constexpr size_t WS_P = WS_HB + (size_t)T * D * 2;
constexpr size_t WS_LF = WS_P + (size_t)T * INC * 2;
constexpr size_t WS_MIX = WS_LF + (size_t)T * 1024 * 4;
constexpr size_t WS_KV = WS_MIX + (size_t)T * D * 2;
constexpr size_t WS_DEC = WS_KV + (size_t)NB * 8 * NCH * 128 * 128 * 4;
constexpr size_t WS_ST = WS_DEC + (size_t)NB * 8 * NCH * 128 * 4;
constexpr size_t WS_ACT = WS_ST + (size_t)NB * 8 * NCH * 128 * 128 * 2;
constexpr size_t WS_Y1 = WS_ACT + (size_t)20480 * DE * 2;
constexpr size_t WS_HRAW = WS_Y1 + (size_t)T * D * 2;
constexpr size_t WS_END = WS_HRAW + (size_t)T * 1024 * 4;
constexpr int CW_TMO = 0;
constexpr int CW_CNT = 64;
constexpr int CW_BAR = 4096;

constexpr int RING_BYTES = 131072, LDSCTL_OFF = RING_BYTES, LDS_TB_OFF = LDSCTL_OFF + 64, MISC_OFF = LDSCTL_OFF + 320, LDS_BYTES = 147456;

#define RLX_AGENT __ATOMIC_RELAXED, __HIP_MEMORY_SCOPE_AGENT
#define LDS_WAIT() asm volatile("s_waitcnt lgkmcnt(0)" ::: "memory")
#define VM_WAIT() asm volatile("s_waitcnt vmcnt(0)" ::: "memory")

#define XB_TMO      128
#define XB_XCNT(j)  (256  + 64 * (j))
#define XB_XSUB(j)  (1280 + 64 * (j))
#define XB_XGEN(j)  (2304 + 64 * (j))
#define XB_TOP      3328
#define XB_TOPGEN   3392
#define XCD_BAR_WORDS 3456
#define XB_SPIN_CAP (1u << 22)
__device__ __forceinline__ unsigned xb_ld(unsigned* p)              { return __hip_atomic_load(p, __ATOMIC_RELAXED, __HIP_MEMORY_SCOPE_AGENT); }
__device__ __forceinline__ unsigned xb_add(unsigned* p, unsigned v) { return __hip_atomic_fetch_add(p, v, __ATOMIC_RELAXED, __HIP_MEMORY_SCOPE_AGENT); }
__device__ __forceinline__ unsigned xb_xcc_id() { return (unsigned)__builtin_amdgcn_s_getreg((3 << 11) | 20) & 0xFu; }
#define XB_SPIN(cond, bar) do { unsigned _sp = 0; while (cond) { __builtin_amdgcn_s_sleep(1); \
    if ((++_sp & 255u) == 0u) { if (xb_ld(&(bar)[XB_TMO])) break; if (_sp > XB_SPIN_CAP) { atomicAdd(&(bar)[XB_TMO], 1u); break; } } } } while (0)
struct XcdBarrier { unsigned* bar; unsigned x; volatile LAS unsigned* st; };
__device__ __forceinline__ XcdBarrier xcd_barrier_post(unsigned* bar, volatile LAS unsigned* st) {
    XcdBarrier b; b.bar = bar; b.x = xb_xcc_id(); b.st = st;
    if (threadIdx.x == 0) (void)xb_add(&bar[XB_XCNT(b.x)], 1u);
    return b;
}
__device__ __forceinline__ void xcd_barrier_complete(unsigned* bar, unsigned x, unsigned& nloc, unsigned& nx) {
    const unsigned G = gridDim.x * gridDim.y * gridDim.z;
    unsigned sum, cnt, mine, sp = 0u;
    for (;;) {
        sum = 0u; cnt = 0u; mine = 0u;
#pragma unroll
        for (unsigned j = 0; j < 16; ++j) { const unsigned c = xb_ld(&bar[XB_XCNT(j)]); sum += c; cnt += (c > 0u) ? 1u : 0u; mine = (j == x) ? c : mine; }
        if (sum == G) break;
        __builtin_amdgcn_s_sleep(1);
        if ((++sp & 255u) == 0u) { if (xb_ld(&bar[XB_TMO])) break; if (sp > XB_SPIN_CAP) { atomicAdd(&bar[XB_TMO], 1u); break; } }
    }
    nloc = mine > 0u ? mine : 1u; nx = cnt > 0u ? cnt : 1u;
}
__device__ __forceinline__ void xcd_barrier(const XcdBarrier& b) {
    asm volatile("s_waitcnt vmcnt(0)" ::: "memory");
    __syncthreads();
    if (threadIdx.x == 0) {
        unsigned* bar = b.bar;
        __builtin_amdgcn_s_waitcnt(0);
        unsigned nloc = b.st[0], nx = b.st[1];
        if (nloc == 0u) { xcd_barrier_complete(bar, b.x, nloc, nx); b.st[0] = nloc; b.st[1] = nx; }
        const unsigned old = xb_add(&bar[XB_XSUB(b.x)], 1u);
        const unsigned gen = old / nloc;
        if (old + 1u == (gen + 1u) * nloc) {
            __builtin_amdgcn_fence(__ATOMIC_RELEASE, "agent");
            asm volatile("s_waitcnt vmcnt(0)" ::: "memory");
            const unsigned og = xb_add(&bar[XB_TOP], 1u);
            const unsigned tg = og / nx;
            if (og + 1u == (tg + 1u) * nx) xb_add(&bar[XB_TOPGEN], 1u);
            else XB_SPIN(xb_ld(&bar[XB_TOPGEN]) == tg, bar);
            __builtin_amdgcn_fence(__ATOMIC_ACQUIRE, "agent");
            xb_add(&bar[XB_XGEN(b.x)], 1u);
            asm volatile("s_waitcnt vmcnt(0)" ::: "memory");
        } else {
            XB_SPIN(xb_ld(&bar[XB_XGEN(b.x)]) == gen, bar);
            __builtin_amdgcn_fence(__ATOMIC_ACQUIRE, "agent");
            asm volatile("s_waitcnt vmcnt(0)" ::: "memory");
        }
    }
    __syncthreads();
}

__device__ __forceinline__ void transpose_item(const float* W, int K, int N, bf16_t* WT, int k0, int n0, int drow0, LAS float* scr, int lane) {
#pragma unroll 8
    for (int i = 0; i < 32; ++i) { const int kk = 2 * i + (lane >> 5); scr[kk * 33 + (lane & 31)] = W[(size_t)(k0 + kk) * N + n0 + (lane & 31)]; }
    LDS_WAIT(); asm volatile("" ::: "memory");
    const int c = lane & 7;
#pragma unroll
    for (int j = 0; j < 4; ++j) { const int n = (lane >> 3) + 8 * j; const LAS float* s = scr + (8 * c) * 33 + n;
        u32x4 o; o.x = pk2(s[0 * 33], s[1 * 33]); o.y = pk2(s[2 * 33], s[3 * 33]); o.z = pk2(s[4 * 33], s[5 * 33]); o.w = pk2(s[6 * 33], s[7 * 33]);
        *(u32x4*)(WT + (size_t)(drow0 + n) * K + k0 + 8 * c) = o; }
    LDS_WAIT(); asm volatile("" ::: "memory");
}

struct Args { const float* in[22]; float* out; unsigned char* ws; int l_lo, l_hi, ph_lo, ph_hi, one, pad; };
enum { PH_PRO = 0, PH_NORM1 = 1, PH_PROJ = 2, PH_ATT = 3, PH_SCAN = 4, PH_HG3 = 5, PH_OUT = 6, PH_ROUTE = 7, PH_UP = 8, PH_DOWN = 9, PH_FINAL = 10 };

template <bool ROUTER>
__device__ __forceinline__ void norm_rows(const Args& args, unsigned char* ws, int l, int wg, int tid, int wave, int lane, LAS unsigned char* lds, bool addy, const float* gain, int shift_idx, int scale_idx) {
    float* Xp = (float*)(ws + WS_X); const bf16_t* Y1p = (const bf16_t*)(ws + WS_Y1); bf16_t* HBp = (bf16_t*)(ws + WS_HB);
    const float* modl = (const float*)(ws + WS_MOD) + (size_t)l * NB * MODW;
    const int row0 = wg * 32, b = row0 / S;
    const float* sh = modl + b * MODW + shift_idx * D; const float* sc = modl + b * MODW + scale_idx * D;
    LAS float* wr = (LAS float*)lds;
    if (ROUTER) {
        const float* w_router = args.in[16];
        for (int i = tid; i < D * NE / 4; i += NTHR) { const f32x4 v = *(const f32x4*)(w_router + 4 * i); const int j = i >> 2, e = (i & 3) * 4;
            wr[(e + 0) * D + j] = v[0]; wr[(e + 1) * D + j] = v[1]; wr[(e + 2) * D + j] = v[2]; wr[(e + 3) * D + j] = v[3]; }
        __syncthreads();
    }
    f32x4 ga[8], sv[8];
#pragma unroll
    for (int j = 0; j < 8; ++j) { const int c = 4 * lane + 256 * j; const f32x4 g = *(const f32x4*)(gain + c), s1 = *(const f32x4*)(sc + c); ga[j] = g * (s1 + 1.f); sv[j] = *(const f32x4*)(sh + c); }
    for (int i = 0; i < 4; ++i) {
        const int row = row0 + wave + 8 * i;
        float* xr = Xp + (size_t)row * D;
        f32x4 v[8]; float ss = 0.f;
#pragma unroll
        for (int j = 0; j < 8; ++j) { const int c = 4 * lane + 256 * j; v[j] = *(const f32x4*)(xr + c);
            if (addy) { const u32x2 y = *(const u32x2*)(Y1p + (size_t)row * D + c); v[j][0] += bflo(y.x); v[j][1] += bfhi(y.x); v[j][2] += bflo(y.y); v[j][3] += bfhi(y.y); *(f32x4*)(xr + c) = v[j]; }
            ss += (v[j][0] * v[j][0] + v[j][1] * v[j][1]) + (v[j][2] * v[j][2] + v[j][3] * v[j][3]); }
        const float r = rsqrtf(wave_sum(ss) * (1.f / D) + EPS);
#pragma unroll
        for (int j = 0; j < 8; ++j) { const int c = 4 * lane + 256 * j; v[j] = v[j] * r * ga[j] + sv[j];
            u32x2 o; o.x = pk2(v[j][0], v[j][1]); o.y = pk2(v[j][2], v[j][3]); *(u32x2*)(HBp + (size_t)row * D + c) = o; }
        if (ROUTER) {
            float mine = 0.f;
#pragma unroll 1
            for (int e = 0; e < NE; ++e) { float a = 0.f;
#pragma unroll
                for (int j = 0; j < 8; ++j) { const f32x4 w = *(const LAS f32x4*)(wr + e * D + 4 * lane + 256 * j); a += (v[j][0] * w[0] + v[j][1] * w[1]) + (v[j][2] * w[2] + v[j][3] * w[3]); }
                a = wave_sum(a); if (lane == e) mine = a; }
            float p[NE];
#pragma unroll
            for (int e = 0; e < NE; ++e) p[e] = __shfl(mine, e);
            if (lane == 0) {
                const float* b_router = args.in[17];
                float m = -1e30f;
#pragma unroll
                for (int e = 0; e < NE; ++e) { p[e] += b_router[e]; m = fmaxf(m, p[e]); }
                float s = 0.f;
#pragma unroll
                for (int e = 0; e < NE; ++e) { p[e] = expf(p[e] - m); s += p[e]; }
#pragma unroll
                for (int e = 0; e < NE; ++e) p[e] /= s;
                int gs = 0; float best = -1.f;
#pragma unroll
                for (int g = 0; g < 4; ++g) { float a = -1.f, c2 = -1.f;
#pragma unroll
                    for (int q = 0; q < 4; ++q) { const float pv = p[g * 4 + q]; if (pv > a) { c2 = a; a = pv; } else if (pv > c2) c2 = pv; }
                    if (a + c2 > best) { best = a + c2; gs = g; } }
                float q4[4];
#pragma unroll
                for (int q = 0; q < 4; ++q) q4[q] = gs == 0 ? p[q] : gs == 1 ? p[4 + q] : gs == 2 ? p[8 + q] : p[12 + q];
                int e0 = -1, e1 = -1; float v0 = -2.f, v1 = -2.f;
#pragma unroll
                for (int q = 0; q < 4; ++q) { const float pv = q4[q]; if (pv > v0) { v1 = v0; e1 = e0; v0 = pv; e0 = gs * 4 + q; } else if (pv > v1) { v1 = pv; e1 = gs * 4 + q; } }
                const float den = v0 + v1;
                unsigned* cnt = (unsigned*)(ws + WS_CTL) + CW_CNT + 64 * l;
                const int p0 = (int)atomicAdd(&cnt[e0], 1u), p1 = (int)atomicAdd(&cnt[e1], 1u);
                float* roww = (float*)(ws + WS_ROWW); int* rowtok = (int*)(ws + WS_ROWTOK);
                roww[e0 * T + p0] = v0 / den; roww[e1 * T + p1] = v1 / den; rowtok[e0 * T + p0] = row; rowtok[e1 * T + p1] = row | (int)0x80000000;
            }
        }
    }
}

__global__ void __launch_bounds__(NTHR, 2) mk_fwd(Args args) {
    extern __shared__ __attribute__((aligned(16))) unsigned char lds_raw[];
    LAS unsigned char* lds = (LAS unsigned char*)lds_raw;
    const int G = gridDim.x, wg = blockIdx.x;
    const int wave0 = __builtin_amdgcn_readfirstlane(threadIdx.x >> 6);
    XcdBarrier bar;
    {
        const int tid = threadIdx.x; unsigned* ctl = (unsigned*)(args.ws + WS_CTL);
        volatile LAS unsigned* MISC = (volatile LAS unsigned*)(lds + MISC_OFF);
        for (int u = tid; u < (LDS_BYTES - LDSCTL_OFF) / 4; u += NTHR) ((LAS unsigned*)(lds + LDSCTL_OFF))[u] = 0u;
        __syncthreads();
        bar.bar = ctl + CW_BAR; bar.x = 0; bar.st = nullptr;
        if (args.one) bar = xcd_barrier_post(ctl + CW_BAR, MISC + 8);
    }
#define GRID_BAR() do { if (args.one) xcd_barrier(bar); } while (0)
#define IN(k) (args.ph_lo <= (k) && (k) < args.ph_hi)
#define X ((float*)(ws + WS_X))
#define HB ((bf16_t*)(ws + WS_HB))
#define P ((bf16_t*)(ws + WS_P))
#define LF ((float*)(ws + WS_LF))
#define MIX ((bf16_t*)(ws + WS_MIX))
#define ACT ((bf16_t*)(ws + WS_ACT))
#define Y1 ((bf16_t*)(ws + WS_Y1))
#define MOD ((float*)(ws + WS_MOD))
#define LB ((float*)(ws + WS_LB))
#define LAM ((float*)(ws + WS_LAM))
#define PHASE_LOCALS unsigned char* ws = args.ws; asm volatile("" : "+s"(ws)); int tid = wave0 * 64 + (int)__builtin_amdgcn_mbcnt_hi(~0u, __builtin_amdgcn_mbcnt_lo(~0u, 0u)); asm volatile("" : "+v"(tid)); \
    const int lane = tid & 63, wave = wave0; (void)lane; (void)wave; unsigned* ctl = (unsigned*)(ws + WS_CTL); (void)ctl;

#ifndef NO_PRO
    if (args.l_lo == 0 && IN(PH_PRO)) { PHASE_LOCALS
        if (wg == 0) {
            for (int j = tid; j < 1024; j += NTHR) { const float* hl = args.in[13]; float v[DEPTH], m = -1e30f;
                for (int l = 0; l < DEPTH; ++l) { v[l] = hl[l * 1024 + j]; m = fmaxf(m, v[l]); }
                float s = 0.f; for (int l = 0; l < DEPTH; ++l) { v[l] = expf(v[l] - m); s += v[l]; }
                float cum = 0.f; const float s0 = v[0] / s;
                for (int l = 0; l < DEPTH; ++l) { cum += v[l] / s; LB[l * 1024 + j] = fmaxf(cum - s0, 0.f); } }
            if (tid < DEPTH) { float a = 0.f, b = 0.f;
                for (int i = 0; i < 64; ++i) { a += args.in[8][tid * 64 + i] * args.in[9][tid * 64 + i]; b += args.in[10][tid * 64 + i] * args.in[11][tid * 64 + i]; }
                LAM[tid] = expf(a) - expf(b) + (0.8f - 0.6f * expf(-0.3f * (float)tid)); }
        }
        {
            LAS float* ca = (LAS float*)lds; LAS float* red = ca + NB * D;
            for (int i = tid; i < NB * D; i += NTHR) ca[i] = siluf_(args.in[1][i]);
            __syncthreads();
            for (int item = wg; item < DEPTH * 64; item += G) {
                const int l = item >> 6, c0 = (item & 63) * 192;
                if (tid < 384) { const int cg = tid % 48, ks = tid / 48; const float* w = args.in[6] + (size_t)l * D * MODW + c0 + 4 * cg;
                    f32x4 a0 = {0.f, 0.f, 0.f, 0.f}, a1 = a0;
#pragma unroll 8
                    for (int k = ks * 256; k < ks * 256 + 256; ++k) { const f32x4 wv = *(const f32x4*)(w + (size_t)k * MODW); a0 += wv * ca[k]; a1 += wv * ca[D + k]; }
#pragma unroll
                    for (int q = 0; q < 4; ++q) { red[(ks * 2 + 0) * 192 + 4 * cg + q] = a0[q]; red[(ks * 2 + 1) * 192 + 4 * cg + q] = a1[q]; } }
                __syncthreads();
                if (tid < 384) { const int b = tid / 192, c = tid % 192; float s = args.in[7][l * MODW + c0 + c];
                    for (int ks = 0; ks < 8; ++ks) s += red[(ks * 2 + b) * 192 + c];
                    MOD[(size_t)(l * NB + b) * MODW + c0 + c] = s; }
                __syncthreads();
            }
        }
        {
            LAS float* scr = (LAS float*)(lds + wave * 16384);
            const int gw = wg * NWAVES + wave, NGW = G * NWAVES;
            constexpr int I_IN = (D / 64) * (INC / 32), I_OUT = (D / 64) * (D / 32), I_G = (D / 64) * (DE / 32), I_D = (DE / 64) * (D / 32);
            constexpr int N_IN = DEPTH * I_IN, N_OUT = DEPTH * I_OUT, N_G = DEPTH * NE * I_G, N_D = DEPTH * NE * I_D;
            for (int it = gw; it < N_IN + N_OUT + 2 * N_G + N_D; it += NGW) {
                int r = it;
                if (r < N_IN) { const int l = r / I_IN, q = r % I_IN, nblk = INC / 32, kb = q / nblk, nb = q % nblk;
                    transpose_item(args.in[2] + (size_t)l * D * INC, D, INC, (bf16_t*)(ws + WS_WIN) + (size_t)l * INC * D, 64 * kb, 32 * nb, 32 * nb, scr, lane); continue; } r -= N_IN;
                if (r < N_OUT) { const int l = r / I_OUT, q = r % I_OUT, nblk = D / 32, kb = q / nblk, nb = q % nblk;
                    transpose_item(args.in[3] + (size_t)l * D * D, D, D, (bf16_t*)(ws + WS_WOUT) + (size_t)l * D * D, 64 * kb, 32 * nb, 32 * nb, scr, lane); continue; } r -= N_OUT;
                if (r < 2 * N_G) { const int up = r >= N_G; if (up) r -= N_G; const int le = r / I_G, q = r % I_G, nblk = DE / 32, kb = q / nblk, nb = q % nblk, n0 = 32 * nb;
                    transpose_item(args.in[up ? 19 : 18] + (size_t)le * D * DE, D, DE, (bf16_t*)(ws + WS_WGU) + (size_t)le * 1024 * D, 64 * kb, n0, (n0 >> 7) * 256 + (up ? 128 : 0) + (n0 & 127), scr, lane); continue; } r -= 2 * N_G;
                { const int le = r / I_D, q = r % I_D, nblk = D / 32, kb = q / nblk, nb = q % nblk;
                    transpose_item(args.in[20] + (size_t)le * DE * D, DE, D, (bf16_t*)(ws + WS_WD) + (size_t)le * D * DE, 64 * kb, 32 * nb, 32 * nb, scr, lane); }
            }
            for (size_t i = (size_t)(wg * NTHR + tid); i < (size_t)T * D / 4; i += (size_t)G * NTHR) ((f32x4*)X)[i] = ((const f32x4*)args.in[0])[i];
        }
        GRID_BAR();
    }
#endif

    for (int l = args.l_lo; l < args.l_hi; ++l) {
#ifndef NO_NORM1
        if (IN(PH_NORM1)) { PHASE_LOCALS norm_rows<false>(args, ws, l, wg, tid, wave, lane, lds, l > 0, args.in[4] + l * D, 0, 1); GRID_BAR(); }
#endif
#ifndef NO_PROJ
        if (IN(PH_PROJ)) { PHASE_LOCALS
            pg8::Gemm g{HB, (const bf16_t*)(ws + WS_WIN) + (size_t)l * INC * D, D}; pg8::StaticOrder So; So.init(T, INC, G, wg);
            pg8::EpiProj E{P, LF, LB + l * 1024};
            pg8::gemm_phase<pg8::EpiProj, pg8::StaticOrder, false>(lds, g, So, E);
            GRID_BAR();
        }
#endif
        MIXER_PHASES
#ifndef NO_OUT
        if (IN(PH_OUT)) { PHASE_LOCALS const float* modl = MOD + (size_t)l * NB * MODW;
            pg8::Gemm g{MIX, (const bf16_t*)(ws + WS_WOUT) + (size_t)l * D * D, D}; pg8::StaticOrder So; So.init(T, D, G, wg);
            pg8::EpiResid E{X, modl + 2 * D};
            pg8::gemm_phase<pg8::EpiResid, pg8::StaticOrder, false>(lds, g, So, E);
            GRID_BAR();
        }
#endif
#ifndef NO_ROUTE
        if (IN(PH_ROUTE)) { PHASE_LOCALS norm_rows<true>(args, ws, l, wg, tid, wave, lane, lds, false, args.in[5] + l * D, 3, 4); GRID_BAR(); }
#endif
        if (IN(PH_UP) || IN(PH_DOWN)) { PHASE_LOCALS const float* modl = MOD + (size_t)l * NB * MODW; unsigned* cnt = ctl + CW_CNT + 64 * l;
            LAS int* tb = (LAS int*)(lds + LDS_TB_OFF);
            if (tid == 0) { int a = 0; for (int e = 0; e < NE; ++e) { const int n = (int)__hip_atomic_load(&cnt[e], RLX_AGENT); tb[e] = a; tb[17 + e] = n; a += (n + 255) >> 8; } tb[16] = a; }
            __syncthreads();
#ifndef NO_UP
            if (IN(PH_UP)) {
                pg8::Gemm g{HB, (const bf16_t*)(ws + WS_WGU) + (size_t)l * NE * 1024 * D, D}; pg8::MoeOrder So{tb, (const int*)(ws + WS_ROWTOK), 4, G, wg};
                pg8::EpiMoeUp E{ACT, (const float*)(ws + WS_ROWW)};
                pg8::gemm_phase<pg8::EpiMoeUp, pg8::MoeOrder, true>(lds, g, So, E);
                GRID_BAR();
            }
#endif
#ifndef NO_DOWN
            if (IN(PH_DOWN)) {
                pg8::Gemm g{ACT, (const bf16_t*)(ws + WS_WD) + (size_t)l * NE * D * DE, DE}; pg8::MoeOrder So{tb, (const int*)(ws + WS_ROWTOK), 8, G, wg};
                pg8::EpiMoeDown E{X, Y1, modl + 5 * D, (const int*)(ws + WS_ROWTOK)};
                pg8::gemm_phase<pg8::EpiMoeDown, pg8::MoeOrder, false>(lds, g, So, E);
                GRID_BAR();
            }
#endif
        }
    }
    if (args.l_hi == DEPTH && IN(PH_FINAL)) { PHASE_LOCALS
        const int row0 = wg * 32; const float* gain = args.in[21];
        f32x4 ga[8];
#pragma unroll
        for (int j = 0; j < 8; ++j) ga[j] = *(const f32x4*)(gain + 4 * lane + 256 * j);
        for (int i = 0; i < 4; ++i) { const int row = row0 + wave + 8 * i; const float* xr = X + (size_t)row * D; f32x4 v[8]; float ss = 0.f;
#pragma unroll
            for (int j = 0; j < 8; ++j) { const int c = 4 * lane + 256 * j; v[j] = *(const f32x4*)(xr + c); const u32x2 y = *(const u32x2*)(Y1 + (size_t)row * D + c);
                v[j][0] += bflo(y.x); v[j][1] += bfhi(y.x); v[j][2] += bflo(y.y); v[j][3] += bfhi(y.y); ss += (v[j][0] * v[j][0] + v[j][1] * v[j][1]) + (v[j][2] * v[j][2] + v[j][3] * v[j][3]); }
            const float r = rsqrtf(wave_sum(ss) * (1.f / D) + EPS);
#pragma unroll
            for (int j = 0; j < 8; ++j) *(f32x4*)(args.out + (size_t)row * D + 4 * lane + 256 * j) = v[j] * r * ga[j]; }
    }
#undef GRID_BAR
#undef IN
#undef X
#undef HB
#undef P
#undef LF
#undef MIX
#undef ACT
#undef Y1
#undef MOD
#undef LB
#undef LAM
}
__global__ void __launch_bounds__(256) s_attn(const bf16_t* P, const float* rel_bias, const float* lam_p, const float* subln, int layer, bf16_t* MIX) {
    __shared__ float qv[128], s1[S], s2[S], red[8], ob[2][128];
    const int q = blockIdx.x, h = blockIdx.y, b = blockIdx.z, tid = threadIdx.x;
    const size_t rowq = (size_t)(b * S + q) * INC;
    if (tid < 128) qv[tid] = bf2f(P[rowq + C_QD + h * 128 + tid]);
    __syncthreads();
    const int nk = q + 1;
    float m1 = -1e30f, m2 = -1e30f;
    for (int k = tid; k < nk; k += 256) {
        const bf16_t* kr = P + (size_t)(b * S + k) * INC + C_KD + h * 128;
        float d1 = 0.f, d2 = 0.f;
        for (int i = 0; i < 64; ++i) { d1 += qv[i] * bf2f(kr[i]); d2 += qv[64 + i] * bf2f(kr[64 + i]); }
        const int n = q - k; const int bk = n < 128 ? (int)T5B[n] : 31;
        d1 += rel_bias[bk * 16 + 2 * h] * LOG2E; d2 += rel_bias[bk * 16 + 2 * h + 1] * LOG2E;
        s1[k] = d1; s2[k] = d2; m1 = fmaxf(m1, d1); m2 = fmaxf(m2, d2);
    }
    m1 = block_max256(m1, red); m2 = block_max256(m2, red);
    float l1 = 0.f, l2 = 0.f;
    for (int k = tid; k < nk; k += 256) { const float e1 = exp2f(s1[k] - m1), e2 = exp2f(s2[k] - m2); s1[k] = e1; s2[k] = e2; l1 += e1; l2 += e2; }
    l1 = block_sum256(l1, red); l2 = block_sum256(l2, red);
    const float lam = lam_p[layer]; const float i1 = 1.f / l1, i2 = lam / l2;
    const int d = tid & 127, half = tid >> 7;
    float acc = 0.f;
    for (int k = half; k < nk; k += 2) acc += (s1[k] * i1 - s2[k] * i2) * bf2f(P[(size_t)(b * S + k) * INC + C_VD + h * 128 + d]);
    ob[half][d] = acc;
    __syncthreads();
    float o = 0.f;
    if (tid < 128) o = ob[0][tid] + ob[1][tid];
    const float ss = block_sum256(tid < 128 ? o * o : 0.f, red);
    const float lambda_init = 0.8f - 0.6f * expf(-0.3f * (float)layer);
    if (tid < 128) MIX[(size_t)(b * S + q) * D + h * 128 + tid] = (bf16_t)f2bf(o * rsqrtf(ss / 128.f + EPS) * subln[layer * 128 + tid] * (1.f - lambda_init));
}
__global__ void __launch_bounds__(128) s_hgrn(const bf16_t* P, const float* LF, float* hraw) {
    __shared__ float red[2][2][8];
    const int js = blockIdx.x, h = blockIdx.y, b = blockIdx.z, d = threadIdx.x, w = d >> 6;
    float St[8];
    for (int i = 0; i < 8; ++i) St[i] = 0.f;
    for (int t = 0; t < S; ++t) {
        const size_t row = (size_t)(b * S + t);
        const bf16_t* pr = P + row * INC;
        const float f = expf(LF[row * 1024 + h * 128 + d]), kk = bf2f(pr[C_FH + h * 128 + d]), qq = bf2f(pr[C_QH + h * 128 + d]);
        float part[8];
        for (int i = 0; i < 8; ++i) { const float vv = bf2f(pr[C_IH + h * 128 + js * 8 + i]); St[i] = f * St[i] + kk * vv; part[i] = wave_sum(qq * St[i]); }
        if ((d & 63) == 0) for (int i = 0; i < 8; ++i) red[t & 1][w][i] = part[i];
        __syncthreads();
        if (d < 8) hraw[row * 1024 + h * 128 + js * 8 + d] = red[t & 1][0][d] + red[t & 1][1][d];
    }
}
__global__ void __launch_bounds__(256) s_hgrn_post(const float* hraw, const bf16_t* P, const float* hnorm_l, bf16_t* MIX) {
    const int t = blockIdx.x, tid = threadIdx.x;
    float v[4]; float ss = 0.f;
    for (int i = 0; i < 4; ++i) { v[i] = hraw[(size_t)t * 1024 + tid * 4 + i]; ss += v[i] * v[i]; }
    for (int o = 1; o < 32; o <<= 1) ss += __shfl_xor(ss, o);
    const float r = rsqrtf(ss / 128.f + EPS);
    for (int i = 0; i < 4; ++i) { const int j = tid * 4 + i; const float sg = bf2f(P[(size_t)t * INC + C_GH + j]); MIX[(size_t)t * D + 1024 + j] = (bf16_t)f2bf(v[i] * r * hnorm_l[j & 127] * sg); }
}
extern "C" void kernel_launch(void* const* d_in, const int* in_sizes, int n_in, void* d_out, int out_size, void* d_ws, size_t ws_size, hipStream_t stream) {
    static int grid = 0;
    if (grid == 0) {
        if (n_in != 22 || in_sizes[0] != T * D || out_size != T * D || ws_size < WS_END) { fprintf(stderr, "kernel_launch: unexpected shapes / workspace (%d inputs, ws %zu, need %zu)\n", n_in, ws_size, (size_t)WS_END); grid = -1; return; }
        int dev = 0, cus = 0;
        if (hipGetDevice(&dev) != hipSuccess || hipDeviceGetAttribute(&cus, hipDeviceAttributeMultiprocessorCount, dev) != hipSuccess) { grid = -1; return; }
        if (hipFuncSetAttribute((const void*)mk_fwd, hipFuncAttributeMaxDynamicSharedMemorySize, LDS_BYTES) != hipSuccess) { fprintf(stderr, "kernel_launch: hipFuncSetAttribute failed\n"); grid = -1; return; }
        int per_cu = 0;
        if (hipOccupancyMaxActiveBlocksPerMultiprocessor(&per_cu, (const void*)mk_fwd, NTHR, LDS_BYTES) != hipSuccess || per_cu < 1) fprintf(stderr, "kernel_launch: occupancy query reports %d\n", per_cu);
        (void)hipGetLastError();
        grid = cus < 256 ? cus : 256;
        if (grid != 256) fprintf(stderr, "kernel_launch: %d CUs; this kernel is laid out for 256\n", cus);
    }
    if (grid < 0) return;
    (void)hipMemsetAsync((char*)d_ws + WS_CTL, 0, CTL_ZERO_BYTES, stream);
    Args a{};
    for (int i = 0; i < 22; ++i) a.in[i] = (const float*)d_in[i];
    a.out = (float*)d_out; a.ws = (unsigned char*)d_ws;
    unsigned char* ws = (unsigned char*)d_ws;
    auto mk = [&](int l_lo, int l_hi, int ph_lo, int ph_hi, int one) {
        a.l_lo = l_lo; a.l_hi = l_hi; a.ph_lo = ph_lo; a.ph_hi = ph_hi; a.one = one; a.pad = 0;
        hipLaunchKernelGGL(mk_fwd, dim3(grid), dim3(NTHR), LDS_BYTES, stream, a);
    };
#if MK_ONE
    mk(0, DEPTH, 0, 11, 1);
#else
    mk(0, 0, PH_PRO, PH_PRO + 1, 0);
    for (int l = 0; l < DEPTH; ++l) {
        mk(l, l + 1, PH_NORM1, PH_NORM1 + 1, 0);
        mk(l, l + 1, PH_PROJ, PH_PROJ + 1, 0);
        mk(l, l + 1, PH_ATT, PH_ATT + 1, 0);
        mk(l, l + 1, PH_SCAN, PH_SCAN + 1, 0);
        mk(l, l + 1, PH_HG3, PH_HG3 + 1, 0);
        mk(l, l + 1, PH_OUT, PH_OUT + 1, 0);
        mk(l, l + 1, PH_ROUTE, PH_ROUTE + 1, 0);
        mk(l, l + 1, PH_UP, PH_UP + 1, 0);
        mk(l, l + 1, PH_DOWN, PH_DOWN + 1, 0);
    }
    mk(DEPTH, DEPTH, PH_FINAL, PH_FINAL + 1, 0);
#endif
}
```

```cpp
#include <hip/hip_runtime.h>
#include <cstdio>
#include <cstdint>
#include <cmath>

constexpr int NB = 2, S = 4096, D = 2048, T = NB * S, DEPTH = 4;
constexpr int INC = 7168, NMOD = 6, MODW = NMOD * D;
constexpr int NE = 16, DE = 512;
constexpr float EPS = 1e-6f;
constexpr int C_QD = 0, C_KD = 1024, C_VD = 2048, C_QH = 3072, C_FH = 4096, C_IH = 5120, C_GH = 6144;
constexpr float LOG2E = 1.4426950408889634f;
constexpr float QSCALE = 0.125f * LOG2E;
constexpr int NCH = S / 64;

typedef unsigned short bf16_t;
typedef short bf16x8 __attribute__((ext_vector_type(8)));
typedef float f32x4 __attribute__((ext_vector_type(4)));
typedef float f32x16 __attribute__((ext_vector_type(16)));
typedef unsigned u32x4 __attribute__((ext_vector_type(4)));
typedef unsigned u32x2 __attribute__((ext_vector_type(2)));
#define GAS __attribute__((address_space(1)))
#define LAS __attribute__((address_space(3)))

__device__ const unsigned char T5B[128] = {0, 1, 2, 3, 4, 5, 6, 7, 8, 9, 10, 11, 12, 13, 14, 15, 16, 16, 16, 17, 17, 18, 18, 18, 19, 19, 19, 20, 20, 20, 20, 21, 21, 21, 21, 22, 22, 22, 22, 22, 23, 23, 23, 23, 23, 23, 24, 24, 24, 24, 24, 24, 25, 25, 25, 25, 25, 25, 25, 26, 26, 26, 26, 26, 26, 26, 26, 27, 27, 27, 27, 27, 27, 27, 27, 27, 27, 28, 28, 28, 28, 28, 28, 28, 28, 28, 28, 29, 29, 29, 29, 29, 29, 29, 29, 29, 29, 29, 29, 30, 30, 30, 30, 30, 30, 30, 30, 30, 30, 30, 30, 30, 30, 31, 31, 31, 31, 31, 31, 31, 31, 31, 31, 31, 31, 31, 31, 31};

__device__ __forceinline__ float wave_sum(float v) {
#pragma unroll
    for (int o = 1; o < 64; o <<= 1) v += __shfl_xor(v, o);
    return v;
}
__device__ __forceinline__ float wave_max(float v) {
#pragma unroll
    for (int o = 1; o < 64; o <<= 1) v = fmaxf(v, __shfl_xor(v, o));
    return v;
}
__device__ __forceinline__ float block_sum256(float v, float* red) {
    v = wave_sum(v);
    __syncthreads();
    if ((threadIdx.x & 63) == 0) red[threadIdx.x >> 6] = v;
    __syncthreads();
    return red[0] + red[1] + red[2] + red[3];
}
__device__ __forceinline__ float block_max256(float v, float* red) {
    v = wave_max(v);
    __syncthreads();
    if ((threadIdx.x & 63) == 0) red[threadIdx.x >> 6] = v;
    __syncthreads();
    return fmaxf(fmaxf(red[0], red[1]), fmaxf(red[2], red[3]));
}
__device__ __forceinline__ float sigmoidf_(float x) { return 1.f / (1.f + expf(-x)); }
__device__ __forceinline__ float siluf_(float x) { return x / (1.f + expf(-x)); }
__device__ __forceinline__ unsigned f2bf(float f) { unsigned u = __builtin_bit_cast(unsigned, f); return (u + 0x7fffu + ((u >> 16) & 1u)) >> 16; }
__device__ __forceinline__ unsigned pk2(float lo, float hi) { return f2bf(lo) | (f2bf(hi) << 16); }
__device__ __forceinline__ float bf2f(unsigned short h) { return __builtin_bit_cast(float, (unsigned)h << 16); }
__device__ __forceinline__ float bflo(unsigned w) { return __builtin_bit_cast(float, w << 16); }
__device__ __forceinline__ float bfhi(unsigned w) { return __builtin_bit_cast(float, w & 0xffff0000u); }

__device__ __forceinline__ void hgrn_gate(float fr, float lbv, float& logf, float& kk) {
    const float s1 = 1.f / (1.f + expf(-fr)), s2 = 1.f / (1.f + expf(fr));
    const float f = lbv + (1.f - lbv) * s1;
    logf = __logf(fmaxf(f, 1.17549435e-38f)); kk = (1.f - lbv) * s2;
}
#ifndef MK_ONE
#define MK_ONE 1
#endif
namespace pg8 {
constexpr int BM = 256, BK = 64, HALF = 128, HTB = HALF * BK * 2  , STAGE_BYTES = 8 * HTB, NXCD = 8, WGM = 8;
__host__ __device__ __forceinline__ int lds_byte(int r, int c) { const int st = (r >> 4) * 2 + (c >> 5), rr = r & 15, cc = c & 31, ob = rr * 64 + cc * 2; return st * 1024 + (ob ^ (((ob >> 9) & 1) << 5)); }
__host__ __device__ __forceinline__ void stage_rc(int b, int& R, int& C) { const int st = b / 1024, sb = b % 1024, swz = sb ^ (((sb >> 9) & 1) << 5); R = (st >> 1) * 16 + swz / 64; C = (st & 1) * 32 + (swz % 64) / 2; }
__host__ __device__ __forceinline__ int perm32(int rho) { const int n = rho >> 4, i = rho & 15; return 8 * (i >> 2) + 4 * n + (i & 3); }

struct Unit { int pm, pn, e, ct, r0, n; };
struct Gemm { const bf16_t* A; const bf16_t* Bt; int K; };

struct StaticOrder {
    int nM, nN, nwg, G, c;
    __device__ void init(int M, int N, int G_, int c_) { nM = M / BM; nN = N / BM; nwg = nM * nN; G = G_; c = c_; }
    __device__ bool next(int i, Unit& u) const {
        const long L = (long)i * G + c; if (L >= nwg) return false;
        int wgid = (int)L; { const int q = nwg / NXCD, r = nwg % NXCD, xcd = wgid % NXCD, off = wgid / NXCD; wgid = (xcd < r ? xcd * (q + 1) : r * (q + 1) + (xcd - r) * q) + off; }
        const int nig = WGM * nN, gid = wgid / nig, fm = gid * WGM, gsz = (nM - fm) < WGM ? (nM - fm) : WGM;
        u.pm = fm + ((wgid % nig) % gsz); u.pn = (wgid % nig) / gsz; u.e = 0; u.ct = u.pn; u.r0 = 0; u.n = 0; return true;
    }
    __device__ __forceinline__ int arow(const Unit&, int) const { return 0; }
};
__device__ __forceinline__ int moe_entry(const LAS int* pre, int e, int p) {
    const LAS int* q = pre + e * 257; int lo = 0;
#pragma unroll
    for (int s = 128; s >= 1; s >>= 1) lo = (q[lo + s] <= p) ? lo + s : lo;
    return (lo * 16 + e) * 32 + (p - q[lo]);
}
struct MoeOrder {
    const LAS int* tb; const LAS int* pre; const int* wgtok; int ncol, G, c;
    __device__ bool next(int i, Unit& u) const {
        const int L = i * G + c; if (L >= tb[16] * ncol) return false;
        const int rt = L / ncol, ct = L - rt * ncol; int e = 0;
        while (tb[e + 1] <= rt) ++e;
        u.e = e; u.ct = ct; u.pm = rt; u.pn = e * ncol + ct; u.r0 = (rt - tb[e]) * 256; u.n = tb[17 + e]; return true;
    }
    __device__ __forceinline__ int arow(const Unit& u, int r) const { const int lr = u.r0 + r; return lr < u.n ? (wgtok[moe_entry(pre, u.e, lr)] & 0x7fffffff) : 0; }
};

__device__ __forceinline__ unsigned cvt_pk_bf16(float lo, float hi) { unsigned r; asm volatile("v_cvt_pk_bf16_f32 %0, %1, %2" : "=v"(r) : "v"(lo), "v"(hi)); return r; }

struct EpiProj {
    static constexpr bool PERM = true;
    bf16_t* P; float* LF; const float* lb;
    __device__ __forceinline__ void operator()(const f32x4 (&acc)[2][2][4][2], const Unit& u, int wr, int wc, int fr, int fq) const {
        const int row0 = u.pm * BM + wr * 64 + fr, colt = u.pn * BM, type = colt >> 10, col0 = colt + wc * 32 + 8 * fq;
#pragma unroll
        for (int ai = 0; ai < 2; ++ai)
#pragma unroll
            for (int m = 0; m < 4; ++m) { const int row = row0 + ai * HALF + m * 16; bf16_t* rowp = P + (size_t)row * INC + col0;
#pragma unroll
                for (int bj = 0; bj < 2; ++bj) { f32x4 v0 = acc[ai][bj][m][0], v1 = acc[ai][bj][m][1];
                    if (type == 0) { v0 = v0 * QSCALE; v1 = v1 * QSCALE; }
                    else if (type == 4) { const int ci = col0 + bj * HALF - C_FH; const f32x4 l0 = *(const f32x4*)(lb + ci), l1 = *(const f32x4*)(lb + ci + 4); f32x4 g0, g1;
#pragma unroll
                        for (int j = 0; j < 4; ++j) { float lf, kk; hgrn_gate(v0[j], l0[j], lf, kk); g0[j] = lf; v0[j] = kk; hgrn_gate(v1[j], l1[j], lf, kk); g1[j] = lf; v1[j] = kk; }
                        float* lfp = LF + (size_t)row * 1024 + ci; *(f32x4*)lfp = g0; *(f32x4*)(lfp + 4) = g1; }
                    else if (type == 6) {
#pragma unroll
                        for (int j = 0; j < 4; ++j) { v0[j] = siluf_(v0[j]); v1[j] = siluf_(v1[j]); } }
                    u32x4 w; w.x = cvt_pk_bf16(v0[0], v0[1]); w.y = cvt_pk_bf16(v0[2], v0[3]); w.z = cvt_pk_bf16(v1[0], v1[1]); w.w = cvt_pk_bf16(v1[2], v1[3]);
                    *(u32x4*)(rowp + bj * HALF) = w; } }
    }
};
struct EpiResid {
    static constexpr bool PERM = false;
    const float* X; float* Xw; const float* gate;
    __device__ __forceinline__ void operator()(const f32x4 (&acc)[2][2][4][2], const Unit& u, int wr, int wc, int fr, int fq) const {
        const int row0 = u.pm * BM + wr * 64 + fr, col0 = u.pn * BM + wc * 32 + 4 * fq; const int b = (u.pm * BM) / S;
        f32x4 gv[2][2];
#pragma unroll
        for (int bj = 0; bj < 2; ++bj)
#pragma unroll
            for (int n = 0; n < 2; ++n) gv[bj][n] = *(const f32x4*)(gate + b * MODW + col0 + bj * HALF + n * 16);
#pragma unroll
        for (int ai = 0; ai < 2; ++ai)
#pragma unroll
            for (int m = 0; m < 4; ++m) { const size_t ro = (size_t)(row0 + ai * HALF + m * 16) * D + col0;
#pragma unroll
                for (int bj = 0; bj < 2; ++bj)
#pragma unroll
                    for (int n = 0; n < 2; ++n) { const size_t o = ro + bj * HALF + n * 16; *(f32x4*)(Xw + o) = *(const f32x4*)(X + o) + gv[bj][n] * acc[ai][bj][m][n]; } }
    }
};
struct EpiMoeUp {
    static constexpr bool PERM = true;
    bf16_t* act; const float* wgw; const LAS int* pre;
    __device__ __forceinline__ void operator()(const f32x4 (&acc)[2][2][4][2], const Unit& u, int wr, int wc, int fr, int fq) const {
        const int col0 = u.ct * 128 + wc * 32 + 8 * fq;
#pragma unroll
        for (int ai = 0; ai < 2; ++ai)
#pragma unroll
            for (int m = 0; m < 4; ++m) { const int r = ai * HALF + wr * 64 + m * 16 + fr, lr = u.r0 + r;
                if (lr < u.n) { const float w = wgw[moe_entry(pre, u.e, lr)]; const f32x4 g0 = acc[ai][0][m][0], g1 = acc[ai][0][m][1], u0 = acc[ai][1][m][0], u1 = acc[ai][1][m][1]; f32x4 a0, a1;
#pragma unroll
                    for (int j = 0; j < 4; ++j) { a0[j] = siluf_(g0[j]) * u0[j] * w; a1[j] = siluf_(g1[j]) * u1[j] * w; }
                    u32x4 o; o.x = cvt_pk_bf16(a0[0], a0[1]); o.y = cvt_pk_bf16(a0[2], a0[3]); o.z = cvt_pk_bf16(a1[0], a1[1]); o.w = cvt_pk_bf16(a1[2], a1[3]);
                    *(u32x4*)(act + (size_t)(u.pm * BM + r) * DE + col0) = o; } }
    }
};
struct EpiMoeDown {
    static constexpr bool PERM = false;
    const float* X; float* Xw; bf16_t* Y1; const float* gate; const int* wgtok; const LAS int* pre;
    __device__ __forceinline__ void operator()(const f32x4 (&acc)[2][2][4][2], const Unit& u, int wr, int wc, int fr, int fq) const {
        const int col0 = u.ct * BM + wc * 32 + 4 * fq;
#pragma unroll
        for (int ai = 0; ai < 2; ++ai)
#pragma unroll
            for (int m = 0; m < 4; ++m) { const int lr = u.r0 + ai * HALF + wr * 64 + m * 16 + fr;
                if (lr < u.n) { const int ts = wgtok[moe_entry(pre, u.e, lr)], tok = ts & 0x7fffffff; const float* gp = gate + (tok / S) * MODW + col0;
                    if (ts >= 0) { const size_t ro = (size_t)tok * D + col0;
#pragma unroll
                        for (int bj = 0; bj < 2; ++bj)
#pragma unroll
                            for (int n = 0; n < 2; ++n) { const size_t o = ro + bj * HALF + n * 16; *(f32x4*)(Xw + o) = *(const f32x4*)(X + o) + *(const f32x4*)(gp + bj * HALF + n * 16) * acc[ai][bj][m][n]; } }
                    else { bf16_t* rowp = Y1 + (size_t)tok * D + col0;
#pragma unroll
                        for (int bj = 0; bj < 2; ++bj)
#pragma unroll
                            for (int n = 0; n < 2; ++n) { const f32x4 v = *(const f32x4*)(gp + bj * HALF + n * 16) * acc[ai][bj][m][n]; u32x2 o; o.x = cvt_pk_bf16(v[0], v[1]); o.y = cvt_pk_bf16(v[2], v[3]);
                                *(u32x2*)(rowp + bj * HALF + n * 16) = o; } } } }
    }
};

template <class Epi, class Sched, bool GATHER = false>
__device__ __forceinline__ void gemm_phase(LAS unsigned char* lds, const Gemm g, const Sched& S, const Epi& E, int tid_in) {
    int tid_ = tid_in; asm volatile("" : "+v"(tid_));
    const int tid = tid_, wid = __builtin_amdgcn_readfirstlane(tid >> 6), lane = tid & 63, wr = wid >> 2, wc = wid & 3, fr = lane & 15, fq = lane >> 4;
    const int K = g.K, nt = K / BK;
    unsigned voffA[2], voffB[2]; int RA[2], CA[2];
#pragma unroll
    for (int i = 0; i < 2; ++i) { int R, C; stage_rc(tid * 16 + i * 8192, R, C); const int Rb = Epi::PERM ? ((R & ~31) + perm32(R & 31)) : R;
        voffA[i] = (unsigned)(R * K + C) * 2u; voffB[i] = (unsigned)(Rb * K + C) * 2u; RA[i] = R; CA[i] = C; }
    const size_t kstep = (size_t)(BK * 2);
    const size_t hstep = (size_t)HALF * K * 2;
    const size_t tstep = 2 * hstep;
    const unsigned ldsw = (unsigned)wid * 1024u;
    const int aoff = lds_byte(wr * 64 + fr, fq * 8), boff = lds_byte(wc * 32 + fr, fq * 8);
#define PG8_SA(b, h) (((b) * 2 + (h)) * HTB)
#define PG8_SB(b, h) ((4 + (b) * 2 + (h)) * HTB)
#define PG8_STAGE(bufoff, gbase, voff) do { _Pragma("unroll") for (int _i = 0; _i < 2; ++_i) \
        __builtin_amdgcn_global_load_lds((const unsigned*)((const char*)(gbase) + (voff)[_i]), (LAS unsigned*)(lds + (bufoff) + ldsw + _i * 8192), 16, 0, 0); } while (0)
#define PG8_STAGE_A(b, h, base, GO) do { if constexpr (GATHER) { PG8_STAGE(PG8_SA(b, h), base, GO[h]); } else { PG8_STAGE(PG8_SA(b, h), (base) + (h) * hstep, voffA); } } while (0)
#define PG8_GSET(GO, U) do { if constexpr (GATHER) { _Pragma("unroll") for (int _h = 0; _h < 2; ++_h) _Pragma("unroll") for (int _i = 0; _i < 2; ++_i) \
        GO[_h][_i] = (unsigned)(S.arow(U, _h * HALF + RA[_i]) * K + CA[_i]) * 2u; } } while (0)
#define PG8_LDA(dst, b, h) do { _Pragma("unroll") for (int m = 0; m < 4; ++m) _Pragma("unroll") for (int k = 0; k < 2; ++k) dst[m][k] = *(const LAS bf16x8*)(lds + PG8_SA(b, h) + aoff + m * 2048 + k * 1024); } while (0)
#define PG8_LDB(dst, b, h) do { _Pragma("unroll") for (int n = 0; n < 2; ++n) _Pragma("unroll") for (int k = 0; k < 2; ++k) dst[n][k] = *(const LAS bf16x8*)(lds + PG8_SB(b, h) + boff + n * 2048 + k * 1024); } while (0)
#define PG8_MMA(ai, bj, At, Bt) do { __builtin_amdgcn_s_setprio(1); _Pragma("unroll") for (int m = 0; m < 4; ++m) _Pragma("unroll") for (int n = 0; n < 2; ++n) _Pragma("unroll") for (int k = 0; k < 2; ++k) \
        acc[ai][bj][m][n] = __builtin_amdgcn_mfma_f32_16x16x32_bf16(Bt[n][k], At[m][k], acc[ai][bj][m][n], 0, 0, 0); __builtin_amdgcn_s_setprio(0); } while (0)
#define PG8_WAIT_V(n) asm volatile("s_waitcnt vmcnt(" #n ")" ::: "memory")
#define PG8_WAIT_L(n) asm volatile("s_waitcnt lgkmcnt(" #n ")" ::: "memory")
#define PG8_BAR __builtin_amdgcn_s_barrier()
#define PG8_SCHED __builtin_amdgcn_sched_barrier(0)
    Unit cur, nxt; int ui = 0;
    if (!S.next(0, cur)) return;
    f32x4 acc[2][2][4][2];
#pragma unroll
    for (int a = 0; a < 2; ++a)
#pragma unroll
        for (int b = 0; b < 2; ++b)
#pragma unroll
            for (int m = 0; m < 4; ++m)
#pragma unroll
                for (int n = 0; n < 2; ++n) acc[a][b][m][n] = (f32x4){0.f, 0.f, 0.f, 0.f};
    bf16x8 At[4][2], B0[2][2], B1[2][2];
    unsigned gcur[2][2] = {{0u, 0u}, {0u, 0u}}, gnxt[2][2] = {{0u, 0u}, {0u, 0u}}, gsel[2][2] = {{0u, 0u}, {0u, 0u}};
    const char* cA = GATHER ? (const char*)g.A : (const char*)g.A + (size_t)cur.pm * tstep; const char* cB = (const char*)g.Bt + (size_t)cur.pn * tstep;
    PG8_GSET(gcur, cur);
    PG8_STAGE(PG8_SB(0, 0), cB, voffB); PG8_STAGE(PG8_SB(0, 1), cB + hstep, voffB); PG8_STAGE_A(0, 0, cA, gcur); PG8_STAGE_A(0, 1, cA, gcur);
    if (wr == 1) PG8_BAR;
    PG8_WAIT_V(2); PG8_BAR;
    PG8_STAGE(PG8_SB(1, 0), cB + kstep, voffB); PG8_STAGE_A(1, 0, cA + kstep, gcur); PG8_STAGE(PG8_SB(1, 1), cB + hstep + kstep, voffB);
    PG8_WAIT_V(6); PG8_BAR;
    for (;;) {
        const bool has_next = S.next(ui + 1, nxt);
        const char* nA = GATHER ? (const char*)g.A : (has_next ? (const char*)g.A + (size_t)nxt.pm * tstep : cA); const char* nB = has_next ? (const char*)g.Bt + (size_t)nxt.pn * tstep : cB;
        if constexpr (GATHER) { if (has_next) { PG8_GSET(gnxt, nxt); } else {
#pragma unroll
            for (int h = 0; h < 2; ++h)
#pragma unroll
                for (int i = 0; i < 2; ++i) gnxt[h][i] = gcur[h][i]; } }
        for (int t = 0; t < nt; t += 2) {
            const bool last = (t == nt - 2);
            const char* a1 = cA + (size_t)(t + 1) * kstep;
            const char* a2 = last ? nA : cA + (size_t)(t + 2) * kstep; const char* b2 = last ? nB : cB + (size_t)(t + 2) * kstep;
            const char* a3 = a2 + kstep; const char* b3 = b2 + kstep;
            if constexpr (GATHER) {
#pragma unroll
                for (int h = 0; h < 2; ++h)
#pragma unroll
                    for (int i = 0; i < 2; ++i) gsel[h][i] = last ? gnxt[h][i] : gcur[h][i]; }
            PG8_LDB(B0, 0, 0); PG8_LDB(B1, 0, 1); PG8_SCHED; PG8_LDA(At, 0, 0); PG8_STAGE_A(1, 1, a1, gcur);
            PG8_WAIT_V(8); PG8_WAIT_L(0); PG8_BAR; PG8_MMA(0, 0, At, B0); PG8_MMA(0, 1, At, B1); PG8_BAR; PG8_SCHED;
            PG8_LDA(At, 0, 1); PG8_STAGE(PG8_SB(0, 0), b2, voffB); PG8_STAGE(PG8_SB(0, 1), b2 + hstep, voffB); PG8_STAGE_A(0, 0, a2, gsel);
            PG8_WAIT_V(8); PG8_WAIT_L(0); PG8_BAR; PG8_MMA(1, 0, At, B0); PG8_MMA(1, 1, At, B1); PG8_BAR; PG8_SCHED;
            PG8_LDB(B0, 1, 0); PG8_LDB(B1, 1, 1); PG8_SCHED; PG8_LDA(At, 1, 0); PG8_STAGE_A(0, 1, a2, gsel);
            PG8_WAIT_V(8); PG8_WAIT_L(0); PG8_BAR; PG8_MMA(0, 0, At, B0); PG8_MMA(0, 1, At, B1); PG8_BAR; PG8_SCHED;
            PG8_LDA(At, 1, 1); PG8_STAGE(PG8_SB(1, 0), b3, voffB); PG8_STAGE(PG8_SB(1, 1), b3 + hstep, voffB); PG8_STAGE_A(1, 0, a3, gsel);
            PG8_WAIT_V(8); PG8_WAIT_L(0); PG8_BAR; PG8_MMA(1, 0, At, B0); PG8_MMA(1, 1, At, B1); PG8_BAR; PG8_SCHED;
        }
        if (wr == 0) PG8_BAR;
        E(acc, cur, wr, wc, fr, fq);
        if (!has_next) break;
#pragma unroll
        for (int a = 0; a < 2; ++a)
#pragma unroll
            for (int b = 0; b < 2; ++b)
#pragma unroll
                for (int m = 0; m < 4; ++m)
#pragma unroll
                    for (int n = 0; n < 2; ++n) acc[a][b][m][n] = (f32x4){0.f, 0.f, 0.f, 0.f};
        cur = nxt; cA = nA; cB = nB; ++ui;
        if constexpr (GATHER) {
#pragma unroll
            for (int h = 0; h < 2; ++h)
#pragma unroll
                for (int i = 0; i < 2; ++i) gcur[h][i] = gnxt[h][i]; }
        if (wr == 1) PG8_BAR;
    }
    PG8_WAIT_V(0);
    PG8_BAR;
#undef PG8_SA
#undef PG8_SB
#undef PG8_STAGE
#undef PG8_STAGE_A
#undef PG8_GSET
#undef PG8_LDA
#undef PG8_LDB
#undef PG8_MMA
#undef PG8_WAIT_V
#undef PG8_WAIT_L
#undef PG8_BAR
#undef PG8_SCHED
}
}
namespace att {
typedef short s16x4 __attribute__((ext_vector_type(4)));
constexpr int KVBLK = 64, SHM_V = KVBLK * 128 * 2, SHM_K = KVBLK * 128 * 2;
constexpr int OFF_V = 0, OFF_K = 2 * SHM_V, OFF_WS = OFF_K + 2 * SHM_K, OFF_BL = OFF_WS + 8 * 64 * 4, LDS_ATT = OFF_BL + 2 * 128 * 4;
constexpr float THR = 8.f;
#define AT_KSWZ(row, colB) ((row) * 256 + ((colB) ^ (((row) & 15) << 4)))
#define AT_SBAR() __builtin_amdgcn_sched_barrier(0)
__device__ __forceinline__ int crow(int r, int hi) { return (r & 3) + 8 * (r >> 2) + 4 * hi; }
__device__ __forceinline__ unsigned cvtpk(float lo, float hi) { unsigned r; asm volatile("v_cvt_pk_bf16_f32 %0, %1, %2" : "=v"(r) : "v"(lo), "v"(hi)); return r; }

__device__ __forceinline__ void partialSM(f32x16& p0, f32x16& p1, float& m_reg, float& alpha) {
    float pmax = p0[0];
#pragma unroll
    for (int r = 1; r < 16; ++r) pmax = fmaxf(pmax, p0[r]);
#pragma unroll
    for (int r = 0; r < 16; ++r) pmax = fmaxf(pmax, p1[r]);
    { auto rr = __builtin_amdgcn_permlane32_swap(__float_as_uint(pmax), __float_as_uint(pmax), false, false); pmax = fmaxf(__uint_as_float(rr[0]), __uint_as_float(rr[1])); }
    float mn;
    if (__builtin_expect(__all(pmax - m_reg <= THR), 1)) { mn = m_reg; alpha = 1.f; }
    else { mn = fmaxf(m_reg, pmax); alpha = __builtin_amdgcn_exp2f(m_reg - mn); m_reg = mn; }
#pragma unroll
    for (int r = 0; r < 16; ++r) { p0[r] -= mn; p1[r] -= mn; }
#pragma unroll
    for (int r = 0; r < 16; ++r) p0[r] = __builtin_amdgcn_exp2f(p0[r]);
}
__device__ __forceinline__ void finishSM(f32x16& p0, f32x16& p1, float alpha, float& l_reg, bf16x8& pa0, bf16x8& pa1, bf16x8& pa2, bf16x8& pa3) {
#pragma unroll
    for (int r = 0; r < 16; ++r) p1[r] = __builtin_amdgcn_exp2f(p1[r]);
    float ps = 0.f;
#pragma unroll
    for (int r = 0; r < 16; ++r) ps += p0[r];
#pragma unroll
    for (int r = 0; r < 16; ++r) ps += p1[r];
    { auto rr = __builtin_amdgcn_permlane32_swap(__float_as_uint(ps), __float_as_uint(ps), false, false); ps = __uint_as_float(rr[0]) + __uint_as_float(rr[1]); }
    l_reg = l_reg * alpha + ps;
#define AT_PK4(Pv, BASE, OUT) do { unsigned a0 = cvtpk(Pv[BASE + 0], Pv[BASE + 1]), a1 = cvtpk(Pv[BASE + 2], Pv[BASE + 3]);   \
    unsigned b0 = cvtpk(Pv[BASE + 4], Pv[BASE + 5]), b1 = cvtpk(Pv[BASE + 6], Pv[BASE + 7]);                              \
    auto r0 = __builtin_amdgcn_permlane32_swap(a0, b0, false, false); auto r1 = __builtin_amdgcn_permlane32_swap(a1, b1, false, false); \
    u32x4 w = {r0[0], r1[0], r0[1], r1[1]}; OUT = __builtin_bit_cast(bf16x8, w); } while (0)
    AT_PK4(p0, 0, pa0); AT_PK4(p0, 8, pa1); AT_PK4(p1, 0, pa2); AT_PK4(p1, 8, pa3);
#undef AT_PK4
}
__device__ __forceinline__ void qkt(f32x16& p0, f32x16& p1, const LAS char* Ks, const bf16x8* qr, int kb) {
    p0 = f32x16{}; p1 = f32x16{};
#pragma unroll
    for (int d0 = 0; d0 < 4; ++d0) {
        const bf16x8 b0 = *(const LAS bf16x8*)(Ks + (kb ^ (d0 * 32)));
        const bf16x8 b1 = *(const LAS bf16x8*)(Ks + 32 * 256 + (kb ^ (d0 * 32)));
        p0 = __builtin_amdgcn_mfma_f32_32x32x16_bf16(b0, qr[d0], p0, 0, 0, 0);
        p1 = __builtin_amdgcn_mfma_f32_32x32x16_bf16(b1, qr[d0], p1, 0, 0, 0); }
}
__device__ __forceinline__ void adj(f32x16& p0, f32x16& p1, int q, int k0, int hi, const LAS float* bl) {
#pragma unroll
    for (int r = 0; r < 16; ++r) { const int rel0 = q - (k0 + crow(r, hi)), rel1 = rel0 - 32;
        const float b0 = bl[min(max(rel0, 0), 127)], b1 = bl[min(max(rel1, 0), 127)];
        p0[r] = rel0 >= 0 ? p0[r] + b0 : -1e30f; p1[r] = rel1 >= 0 ? p1[r] + b1 : -1e30f; }
}
__device__ __forceinline__ int v_st(int k, int c) { const int kk = (k & ~0xC) | ((k & 4) << 1) | ((k & 8) >> 1); return ((kk >> 3) * 4 + (c >> 5)) * 512 + ((kk & 7) * 32 + (c & 31)) * 2; }
__device__ __forceinline__ int v_rd_base(int lane) { return ((lane & 3) << 3) | (((lane >> 2) & 3) << 6) | (((lane >> 4) & 1) << 5) | (((lane >> 5) & 1) << 8); }
constexpr int v_rd_off(int d0, int ks, int half) { return d0 * 512 + ks * 4096 + half * 2048; }
template <int OFF> __device__ __forceinline__ s16x4 tr_read(int vb) { s16x4 r; asm volatile("ds_read_b64_tr_b16 %0, %1 offset:%2" : "=&v"(r) : "v"(vb), "i"(OFF) : "memory"); return r; }
template <int D0> __device__ __forceinline__ void pv_one(f32x16& od, int vb, bf16x8 pa0, bf16x8 pa1, bf16x8 pa2, bf16x8 pa3) {
    const s16x4 l0 = tr_read<v_rd_off(D0, 0, 0)>(vb), h0 = tr_read<v_rd_off(D0, 0, 1)>(vb), l1 = tr_read<v_rd_off(D0, 1, 0)>(vb), h1 = tr_read<v_rd_off(D0, 1, 1)>(vb);
    const s16x4 l2 = tr_read<v_rd_off(D0, 2, 0)>(vb), h2 = tr_read<v_rd_off(D0, 2, 1)>(vb), l3 = tr_read<v_rd_off(D0, 3, 0)>(vb), h3 = tr_read<v_rd_off(D0, 3, 1)>(vb);
    asm volatile("s_waitcnt lgkmcnt(0)" ::: "memory"); AT_SBAR();
#define AT_PK(L, H) (bf16x8){L[0], L[1], L[2], L[3], H[0], H[1], H[2], H[3]}
    od = __builtin_amdgcn_mfma_f32_32x32x16_bf16(pa0, AT_PK(l0, h0), od, 0, 0, 0);
    od = __builtin_amdgcn_mfma_f32_32x32x16_bf16(pa1, AT_PK(l1, h1), od, 0, 0, 0);
    od = __builtin_amdgcn_mfma_f32_32x32x16_bf16(pa2, AT_PK(l2, h2), od, 0, 0, 0);
    od = __builtin_amdgcn_mfma_f32_32x32x16_bf16(pa3, AT_PK(l3, h3), od, 0, 0, 0);
#undef AT_PK
}
__device__ __forceinline__ void pv_d0(f32x16* o, int vb, bf16x8 pa0, bf16x8 pa1, bf16x8 pa2, bf16x8 pa3) {
    pv_one<0>(o[0], vb, pa0, pa1, pa2, pa3); pv_one<1>(o[1], vb, pa0, pa1, pa2, pa3); pv_one<2>(o[2], vb, pa0, pa1, pa2, pa3); pv_one<3>(o[3], vb, pa0, pa1, pa2, pa3);
}

__device__ __forceinline__ void attn_unit(int b, int h, int qb, const bf16_t* __restrict__ P, bf16_t* MIX, const float* rel_bias, const float* subln, float lam, float osc, LAS char* lds, int tid) {
    const int wid = __builtin_amdgcn_readfirstlane(tid >> 6), lane = tid & 63, r32 = lane & 31, hi = lane >> 5, jm = wid >> 2, w4 = wid & 3;
    LAS char* V_lds = lds + OFF_V; LAS char* K_lds = lds + OFF_K;
    LAS float* wsf = (LAS float*)(lds + OFF_WS) + wid * 64; LAS float* li_l = wsf; LAS float* al_l = wsf + 32;
    LAS float* bl = (LAS float*)(lds + OFF_BL);
    const int q0 = qb * 128, qw = q0 + w4 * 32, qpos = qw + r32;
    const size_t rowb = (size_t)b * S;
    if (tid < 256) { const int j = tid >> 7, d = tid & 127; bl[tid] = (rel_bias[(int)T5B[d] * 16 + 2 * h + j] - rel_bias[31 * 16 + 2 * h + j]) * LOG2E; }
    float m_reg = -1e30f, l_reg = 0.f; f32x16 o[4] = {}; bf16x8 qr[4];
    { const bf16_t* Qw = P + (rowb + qpos) * INC + C_QD + h * 128 + jm * 64 + hi * 8;
#pragma unroll
      for (int d0 = 0; d0 < 4; ++d0) qr[d0] = *(const bf16x8*)(Qw + d0 * 16); }
    const __amdgpu_buffer_rsrc_t rs = __builtin_amdgcn_make_buffer_rsrc((void*)((const char*)P + (rowb * INC + C_KD + h * 128) * 2), 0, (int)((size_t)S * INC * 2), 0x00020000);
    const int sr = tid >> 4, sc = (tid & 15) * 8, vst0 = v_st(sr, sc), vst1 = v_st(32 + sr, sc);
    const unsigned voff = (unsigned)(sr * INC + sc) * 2u;
    const int kst0 = AT_KSWZ(sr, sc * 2), kst1 = AT_KSWZ(32 + sr, sc * 2);
    const int vb0 = (int)(uintptr_t)V_lds + v_rd_base(lane);
    const int kb = AT_KSWZ(r32, jm * 128 + hi * 16);
    const LAS float* blj = bl + jm * 128;
    struct { bf16x8 vs0, vs1, ks0, ks1; } sr_[2];
#define AT_BL(so) __builtin_bit_cast(bf16x8, __builtin_amdgcn_raw_buffer_load_b128(rs, voff, (so), 0))
#define AT_SLOAD(i, k0) do { const int so_ = (k0) * (INC * 2); \
    sr_[i].vs0 = AT_BL(so_ + (C_VD - C_KD) * 2); sr_[i].vs1 = AT_BL(so_ + (C_VD - C_KD) * 2 + 32 * INC * 2); \
    sr_[i].ks0 = AT_BL(so_); sr_[i].ks1 = AT_BL(so_ + 32 * INC * 2); } while (0)
#define AT_SWRITE(bf, i) do { *(LAS bf16x8*)(V_lds + (bf) * SHM_V + vst0) = sr_[i].vs0; *(LAS bf16x8*)(V_lds + (bf) * SHM_V + vst1) = sr_[i].vs1; \
    *(LAS bf16x8*)(K_lds + (bf) * SHM_K + kst0) = sr_[i].ks0; *(LAS bf16x8*)(K_lds + (bf) * SHM_K + kst1) = sr_[i].ks1; } while (0)
#define AT_SWAIT() asm volatile("s_waitcnt vmcnt(4)" ::: "memory")
#define AT_RESC(a) do { if (__any((a) < 1.f)) { if (hi == 0) al_l[r32] = (a); asm volatile("s_waitcnt lgkmcnt(0)" ::: "memory"); \
    _Pragma("unroll") for (int d = 0; d < 4; ++d) _Pragma("unroll") for (int r = 0; r < 16; ++r) o[d][r] *= al_l[crow(r, hi)]; } } while (0)
#define AT_ADJ(PA, PB, t) do { const int k0_ = (t) * KVBLK; if (qw - (k0_ + 63) < 113) adj(PA, PB, qpos, k0_, hi, blj); } while (0)
    f32x16 pA0, pA1, pB0, pB1; float alA, alB; bf16x8 pa0, pa1, pa2, pa3; const int NT = 2 * qb + 2;
    AT_SLOAD(0, 0); asm volatile("s_waitcnt vmcnt(0)" ::: "memory"); AT_SWRITE(0, 0); __syncthreads();
    qkt(pA0, pA1, K_lds, qr, kb); AT_ADJ(pA0, pA1, 0); partialSM(pA0, pA1, m_reg, alA);
    AT_SLOAD(1, KVBLK); if (2 < NT) AT_SLOAD(0, 2 * KVBLK);
    AT_SWAIT(); AT_SWRITE(1, 1); __syncthreads();
    for (int j = 1; j + 1 < NT; j += 2) {
        AT_SBAR(); qkt(pB0, pB1, K_lds + SHM_K, qr, kb);
        finishSM(pA0, pA1, alA, l_reg, pa0, pa1, pa2, pa3); AT_SBAR();
        AT_SLOAD(1, (j + 2) * KVBLK); AT_SBAR();
        pv_d0(o, vb0, pa0, pa1, pa2, pa3); AT_ADJ(pB0, pB1, j); partialSM(pB0, pB1, m_reg, alB);
        __syncthreads(); AT_SWAIT(); AT_SWRITE(0, 0);
        AT_RESC(alB); __syncthreads();
        AT_SBAR(); qkt(pA0, pA1, K_lds, qr, kb);
        finishSM(pB0, pB1, alB, l_reg, pa0, pa1, pa2, pa3); AT_SBAR();
        if (j + 3 < NT) AT_SLOAD(0, (j + 3) * KVBLK); AT_SBAR();
        pv_d0(o, vb0 + SHM_V, pa0, pa1, pa2, pa3); AT_ADJ(pA0, pA1, j + 1); partialSM(pA0, pA1, m_reg, alA);
        __syncthreads(); AT_SWAIT(); AT_SWRITE(1, 1);
        AT_RESC(alA); __syncthreads();
    }
    AT_SBAR(); qkt(pB0, pB1, K_lds + SHM_K, qr, kb);
    finishSM(pA0, pA1, alA, l_reg, pa0, pa1, pa2, pa3); AT_SBAR();
    pv_d0(o, vb0, pa0, pa1, pa2, pa3); AT_ADJ(pB0, pB1, NT - 1); partialSM(pB0, pB1, m_reg, alB);
    __syncthreads(); AT_RESC(alB);
    finishSM(pB0, pB1, alB, l_reg, pa0, pa1, pa2, pa3); AT_SBAR();
    pv_d0(o, vb0 + SHM_V, pa0, pa1, pa2, pa3);
    int t2 = tid; asm volatile("" : "+v"(t2));
    const int lane2 = t2 & 63, r32b = lane2 & 31, hib = lane2 >> 5;
    if (hib == 0) li_l[r32b] = l_reg; asm volatile("s_waitcnt lgkmcnt(0)" ::: "memory");
    float rli[16];
#pragma unroll
    for (int r = 0; r < 16; ++r) rli[r] = __builtin_amdgcn_rcpf(li_l[crow(r, hib)]);
    __syncthreads();
    LAS float* xch = (LAS float*)lds + (w4 * 64) * 64 + lane2;
    if (jm == 1) {
#pragma unroll
        for (int d0 = 0; d0 < 4; ++d0)
#pragma unroll
            for (int r = 0; r < 16; ++r) xch[(d0 * 16 + r) * 64] = o[d0][r] * rli[r] * lam; }
    __syncthreads();
    if (jm == 0) {
#pragma unroll
        for (int r = 0; r < 16; ++r) { float a = 0.f;
#pragma unroll
            for (int d0 = 0; d0 < 4; ++d0) { const float dv = o[d0][r] * rli[r] - xch[(d0 * 16 + r) * 64]; o[d0][r] = dv; a += dv * dv; }
#pragma unroll
            for (int m = 1; m < 32; m <<= 1) a += __shfl_xor(a, m);
            rli[r] = rsqrtf(a * (1.f / 128.f) + EPS) * osc; }
        float sg[4];
#pragma unroll
        for (int d0 = 0; d0 < 4; ++d0) sg[d0] = subln[32 * d0 + r32b];
        bf16_t* Ow = MIX + (rowb + qw) * D + h * 128 + r32b;
#pragma unroll
        for (int r = 0; r < 16; ++r) { const int orow = crow(r, hib);
#pragma unroll
            for (int d0 = 0; d0 < 4; ++d0) Ow[(size_t)orow * D + d0 * 32] = (bf16_t)f2bf(o[d0][r] * rli[r] * sg[d0]); }
    }
    __syncthreads();
#undef AT_SLOAD
#undef AT_BL
#undef AT_SWRITE
#undef AT_SWAIT
#undef AT_RESC
#undef AT_ADJ
}
#undef AT_KSWZ
#undef AT_SBAR
}

namespace hg {
__device__ __forceinline__ int sw128(int r, int c) { return r * 128 + (((c ^ (r >> 1)) & 7) << 4); }
__device__ __forceinline__ int sw256(int r, int c) { return r * 256 + (((c ^ r) & 15) << 4); }
constexpr int OFF_QT = 0, OFF_VT = 2048, OFF_KE = OFF_VT + 16384;
constexpr int OFF_QS = OFF_KE, OFF_QM = OFF_QS + 16384, OFF_KM = OFF_QM + 16384, OFF_AB = OFF_KM + 16384, OFF_OX = OFF_AB + 8192;
constexpr int OXS = 132;
__device__ __forceinline__ int crow(int r, int hi) { return (r & 3) + 8 * (r >> 2) + 4 * hi; }

__device__ __forceinline__ void cumsum_b(const float* LFp, size_t row0, int h, int d, int tq, LAS float* qt, float (&bq)[16], float& bend, float& bmid) {
    float run = 0.f; const float* p = LFp + (row0 + 16 * tq) * 1024 + h * 128 + d;
#pragma unroll
    for (int i = 0; i < 16; ++i) { run += p[(size_t)i * 1024]; bq[i] = run; }
    qt[tq * 128 + d] = run;
    __syncthreads();
    const float q0 = qt[d], q1 = qt[128 + d], q2 = qt[256 + d], q3 = qt[384 + d];
    const float off = tq == 0 ? 0.f : tq == 1 ? q0 : tq == 2 ? q0 + q1 : q0 + q1 + q2;
#pragma unroll
    for (int i = 0; i < 16; ++i) bq[i] += off;
    bend = (q0 + q1) + (q2 + q3); bmid = q0 + q1;
}
__device__ __forceinline__ void hg1_unit(int bh, int c, const bf16_t* __restrict__ Pp, const float* __restrict__ LFp, float* KV, float* DEC, LAS char* lds, int tid) {
    const int d = tid & 127, tq = tid >> 7, h = bh & 7, wid = __builtin_amdgcn_readfirstlane(tid >> 6), lane = tid & 63, r = lane & 31, hh = lane >> 5;
    const size_t row0 = (size_t)(bh >> 3) * S + c * 64;
    float bq[16], bend, bmid;
    cumsum_b(LFp, row0, h, d, tq, (LAS float*)(lds + OFF_QT), bq, bend, bmid);
    { const bf16_t* kp = Pp + (row0 + 16 * tq) * INC + C_FH + h * 128 + d; const bf16_t* vp = Pp + (row0 + 16 * tq) * INC + C_IH + h * 128 + d;
      unsigned kw[8], vw[8];
#pragma unroll
      for (int i = 0; i < 8; ++i) { const float k0 = bf2f(kp[(size_t)(2 * i) * INC]) * __expf(bend - bq[2 * i]), k1 = bf2f(kp[(size_t)(2 * i + 1) * INC]) * __expf(bend - bq[2 * i + 1]);
          kw[i] = pk2(k0, k1); vw[i] = (unsigned)vp[(size_t)(2 * i) * INC] | ((unsigned)vp[(size_t)(2 * i + 1) * INC] << 16); }
      *(LAS u32x4*)(lds + OFF_KE + sw128(d, 2 * tq)) = (u32x4){kw[0], kw[1], kw[2], kw[3]}; *(LAS u32x4*)(lds + OFF_KE + sw128(d, 2 * tq + 1)) = (u32x4){kw[4], kw[5], kw[6], kw[7]};
      *(LAS u32x4*)(lds + OFF_VT + sw128(d, 2 * tq)) = (u32x4){vw[0], vw[1], vw[2], vw[3]}; *(LAS u32x4*)(lds + OFF_VT + sw128(d, 2 * tq + 1)) = (u32x4){vw[4], vw[5], vw[6], vw[7]}; }
    if (tq == 0) DEC[((size_t)bh * NCH + c) * 128 + d] = __expf(bend);
    __syncthreads();
    const int vbase = (wid & 3) * 32;
#pragma unroll
    for (int dt = 0; dt < 2; ++dt) { const int dbase = (wid >> 2) * 64 + dt * 32; f32x16 acc = {};
#pragma unroll
        for (int ks = 0; ks < 4; ++ks) { const bf16x8 a = *(const LAS bf16x8*)(lds + OFF_VT + sw128(vbase + r, 2 * ks + hh)), bb = *(const LAS bf16x8*)(lds + OFF_KE + sw128(dbase + r, 2 * ks + hh));
            acc = __builtin_amdgcn_mfma_f32_32x32x16_bf16(a, bb, acc, 0, 0, 0); }
        float* op = KV + (((size_t)bh * NCH + c) * 128 + vbase) * 128 + dbase + r;
#pragma unroll
        for (int q = 0; q < 16; ++q) op[(size_t)crow(q, hh) * 128] = acc[q]; }
    __syncthreads();
}
__device__ __forceinline__ void hg3_unit(int bh, int c, const bf16_t* __restrict__ Pp, const float* __restrict__ LFp, const bf16_t* __restrict__ ST, const float* hnorm, bf16_t* MIXp, LAS char* lds, int tid) {
    const int d = tid & 127, tq = tid >> 7, h = bh & 7, wid = __builtin_amdgcn_readfirstlane(tid >> 6), lane = tid & 63, r = lane & 31, hh = lane >> 5;
    const size_t row0 = (size_t)(bh >> 3) * S + c * 64;
    float bq[16], bend, bmid;
    cumsum_b(LFp, row0, h, d, tq, (LAS float*)(lds + OFF_QT), bq, bend, bmid);
    { const bf16_t* qp = Pp + (row0 + 16 * tq) * INC + C_QH + h * 128 + d; const bf16_t* kp = Pp + (row0 + 16 * tq) * INC + C_FH + h * 128 + d; const bf16_t* vp = Pp + (row0 + 16 * tq) * INC + C_IH + h * 128 + d;
      unsigned vw[8];
#pragma unroll
      for (int i = 0; i < 16; ++i) { const int t = 16 * tq + i; const float qv = bf2f(qp[(size_t)i * INC]), kv = bf2f(kp[(size_t)i * INC]); const float e1 = __expf(bq[i] - bmid);
          const int o256 = sw256(t, d >> 3) + (d & 7) * 2;
          *(LAS bf16_t*)(lds + OFF_QS + o256) = (bf16_t)f2bf(qv * __expf(bq[i]));
          *(LAS bf16_t*)(lds + OFF_QM + o256) = (bf16_t)f2bf(qv * e1);
          *(LAS bf16_t*)(lds + OFF_KM + o256) = (bf16_t)f2bf(kv * __builtin_amdgcn_rcpf(e1)); }
#pragma unroll
      for (int i = 0; i < 8; ++i) vw[i] = (unsigned)vp[(size_t)(2 * i) * INC] | ((unsigned)vp[(size_t)(2 * i + 1) * INC] << 16);
      *(LAS u32x4*)(lds + OFF_VT + sw128(d, 2 * tq)) = (u32x4){vw[0], vw[1], vw[2], vw[3]}; *(LAS u32x4*)(lds + OFF_VT + sw128(d, 2 * tq + 1)) = (u32x4){vw[4], vw[5], vw[6], vw[7]}; }
    __syncthreads();
    if (wid < 4) { const int ti = wid & 1, si = wid >> 1; f32x16 acc = {};
        if (!(ti == 0 && si == 1)) {
#pragma unroll
            for (int ks = 0; ks < 8; ++ks) { const bf16x8 a = *(const LAS bf16x8*)(lds + OFF_QM + sw256(ti * 32 + r, 2 * ks + hh)), bb = *(const LAS bf16x8*)(lds + OFF_KM + sw256(si * 32 + r, 2 * ks + hh));
                acc = __builtin_amdgcn_mfma_f32_32x32x16_bf16(a, bb, acc, 0, 0, 0); } }
        const int sidx = si * 32 + r;
#pragma unroll
        for (int q = 0; q < 16; ++q) { const int t = ti * 32 + crow(q, hh); const float v = (sidx <= t) ? acc[q] : 0.f;
            *(LAS bf16_t*)(lds + OFF_AB + sw128(t, sidx >> 3) + (sidx & 7) * 2) = (bf16_t)f2bf(v); } }
    __syncthreads();
    {
        const int tb = (wid & 1) * 32, vb = (wid >> 1) * 32; f32x16 acc = {};
        const bf16_t* sp = ST + (((size_t)bh * NCH + c) * 128 + vb + r) * 128 + 8 * hh;
        bf16x8 sf[8];
#pragma unroll
        for (int ks = 0; ks < 8; ++ks) sf[ks] = *(const bf16x8*)(sp + 16 * ks);
#pragma unroll
        for (int ks = 0; ks < 4; ++ks) { const bf16x8 a = *(const LAS bf16x8*)(lds + OFF_AB + sw128(tb + r, 2 * ks + hh)), bb = *(const LAS bf16x8*)(lds + OFF_VT + sw128(vb + r, 2 * ks + hh));
            acc = __builtin_amdgcn_mfma_f32_32x32x16_bf16(a, bb, acc, 0, 0, 0); }
#pragma unroll
        for (int ks = 0; ks < 8; ++ks) { const bf16x8 a = *(const LAS bf16x8*)(lds + OFF_QS + sw256(tb + r, 2 * ks + hh));
            acc = __builtin_amdgcn_mfma_f32_32x32x16_bf16(a, sf[ks], acc, 0, 0, 0); }
        LAS float* ox = (LAS float*)(lds + OFF_OX);
#pragma unroll
        for (int q = 0; q < 16; ++q) ox[(tb + crow(q, hh)) * OXS + vb + r] = acc[q]; }
    __syncthreads();
    {
        const int t = tid >> 3, part = tid & 7; const LAS float* ox = (const LAS float*)(lds + OFF_OX) + t * OXS + part * 16;
        f32x4 v[4]; float ss = 0.f;
#pragma unroll
        for (int i = 0; i < 4; ++i) { v[i] = *(const LAS f32x4*)(ox + 4 * i); ss += (v[i][0] * v[i][0] + v[i][1] * v[i][1]) + (v[i][2] * v[i][2] + v[i][3] * v[i][3]); }
        ss += __shfl_xor(ss, 1); ss += __shfl_xor(ss, 2); ss += __shfl_xor(ss, 4);
        const float rn = rsqrtf(ss * (1.f / 128.f) + EPS);
        const bf16_t* gp = Pp + (row0 + t) * INC + C_GH + h * 128 + part * 16; const u32x4 g0 = *(const u32x4*)gp, g1 = *(const u32x4*)(gp + 8);
        const float* hn = hnorm + part * 16; unsigned ow[8];
#pragma unroll
        for (int i = 0; i < 8; ++i) { const unsigned gw = i < 4 ? g0[i] : g1[i - 4]; const int e = 2 * i;
            ow[i] = pk2(v[e >> 2][e & 3] * rn * hn[e] * bflo(gw), v[(e + 1) >> 2][(e + 1) & 3] * rn * hn[e + 1] * bfhi(gw)); }
        bf16_t* op = MIXp + (row0 + t) * D + 1024 + h * 128 + part * 16;
        *(u32x4*)op = (u32x4){ow[0], ow[1], ow[2], ow[3]}; *(u32x4*)(op + 8) = (u32x4){ow[4], ow[5], ow[6], ow[7]}; }
    __syncthreads();
}
}

#define MIXER_PHASES \
        if (IN(PH_ATT)) { PHASE_LOCALS \
            const float lam = LAM[l]; const float osc = 1.f - (0.8f - 0.6f * expf(-0.3f * (float)l)); \
            for (int pr = wg; pr < 256; pr += G) { const int vcu = (pr & 7) * 32 + (pr >> 3), bh = vcu >> 4, s = vcu & 15; \
                _Pragma("unroll 1") for (int u2 = 0; u2 < 2; ++u2) \
                    att::attn_unit(bh >> 3, bh & 7, u2 ? s : 31 - s, P, MIX, args.in[15], args.in[12] + l * 128, lam, osc, (LAS char*)lds, tid); } \
            for (int u = wg; u < NB * 8 * NCH; u += G) hg::hg1_unit(u >> 6, u & 63, P, LF, (float*)(ws + WS_KV), (float*)(ws + WS_DEC), (LAS char*)lds, tid); \
            GRID_BAR(); } \
        if (IN(PH_SCAN)) { PHASE_LOCALS \
            const float* KV = (const float*)(ws + WS_KV); const float* DEC = (const float*)(ws + WS_DEC); bf16_t* ST = (bf16_t*)(ws + WS_ST); \
            for (int gid = wg * NTHR + tid; gid < NB * 8 * 8192; gid += G * NTHR) { const int bh = gid >> 13, f = (gid & 8191) * 2, dd = f & 127; float s0 = 0.f, s1 = 0.f; \
                _Pragma("unroll 8") for (int c = 0; c < NCH; ++c) { const size_t cb = (size_t)bh * NCH + c; const float2 kv = *(const float2*)(KV + cb * 16384 + f), dc = *(const float2*)(DEC + cb * 128 + dd); \
                    *(unsigned*)(ST + cb * 16384 + f) = pk2(s0, s1); s0 = dc.x * s0 + kv.x; s1 = dc.y * s1 + kv.y; } } \
            GRID_BAR(); } \
        if (IN(PH_HG3)) { PHASE_LOCALS \
            for (int u = wg; u < NB * 8 * NCH; u += G) hg::hg3_unit(u >> 6, u & 63, P, LF, (const bf16_t*)(ws + WS_ST), args.in[14] + l * 128, MIX, (LAS char*)lds, tid); \
            GRID_BAR(); }
constexpr int NWAVES = 8, NTHR = NWAVES * 64;
constexpr size_t MiB = 1u << 20;
constexpr size_t WS_CTL = 0, CTL_ZERO_BYTES = 1 * MiB;
constexpr size_t WS_MOD = 1 * MiB;
constexpr size_t WS_LB = WS_MOD + 512 * 1024;
constexpr size_t WS_LAM = WS_LB + 16 * 1024;
constexpr size_t WS_WGCNT = 2 * MiB;
constexpr size_t WS_WGW = WS_WGCNT + 128 * 1024, WS_WGTOK = WS_WGW + 512 * 1024;
constexpr size_t WS_WIN = 4 * MiB;
constexpr size_t WS_WOUT = WS_WIN + (size_t)DEPTH * INC * D * 2;
constexpr size_t WS_WGU = WS_WOUT + (size_t)DEPTH * D * D * 2;
constexpr size_t WS_WD = WS_WGU + (size_t)DEPTH * NE * 1024 * D * 2;
constexpr size_t WS_X = WS_WD + (size_t)DEPTH * NE * D * DE * 2;
constexpr size_t WS_HB = WS_X + (size_t)T * D * 4;
constexpr size_t WS_P = WS_HB + (size_t)T * D * 2;
constexpr size_t WS_LF = WS_P + (size_t)T * INC * 2;
constexpr size_t WS_MIX = WS_LF + (size_t)T * 1024 * 4;
constexpr size_t WS_KV = WS_MIX + (size_t)T * D * 2;
constexpr size_t WS_DEC = WS_KV + (size_t)NB * 8 * NCH * 128 * 128 * 4;
constexpr size_t WS_ST = WS_DEC + (size_t)NB * 8 * NCH * 128 * 4;
constexpr size_t WS_ACT = WS_ST + (size_t)NB * 8 * NCH * 128 * 128 * 2;
constexpr size_t WS_Y1 = WS_ACT + (size_t)20480 * DE * 2;
constexpr size_t WS_HRAW = WS_Y1 + (size_t)T * D * 2;
constexpr size_t WS_END = WS_HRAW + (size_t)T * 1024 * 4;
constexpr size_t WS_DRY_X = WS_END, WS_DRY_HB = WS_DRY_X + (size_t)T * D * 4, WS_DRY_Y1 = WS_DRY_HB + (size_t)T * D * 2, WS_DRY_SMALL = WS_DRY_Y1 + (size_t)T * D * 2, WS_END2 = WS_DRY_SMALL + 2 * MiB;
constexpr int CW_TMO = 0;
constexpr int CW_CNT = 64;
constexpr int CW_BAR = 4096;

constexpr int RING_BYTES = 131072, LDSCTL_OFF = RING_BYTES, LDS_TB_OFF = LDSCTL_OFF + 64, MISC_OFF = LDSCTL_OFF + 320, LDS_SEL_OFF = LDSCTL_OFF + 1024, LDS_PRE_OFF = LDSCTL_OFF + 2048, LDS_WTOT_OFF = LDS_PRE_OFF + 16 * 257 * 4, LDS_BYTES = 163840;

#define RLX_AGENT __ATOMIC_RELAXED, __HIP_MEMORY_SCOPE_AGENT
#define LDS_WAIT() asm volatile("s_waitcnt lgkmcnt(0)" ::: "memory")
#define VM_WAIT() asm volatile("s_waitcnt vmcnt(0)" ::: "memory")

#define XB_TMO      128
#define XB_XCNT(j)  (256  + 64 * (j))
#define XB_XSUB(j)  (1280 + 64 * (j))
#define XB_XGEN(j)  (2304 + 64 * (j))
#define XB_TOP      3328
#define XB_TOPGEN   3392
#define XCD_BAR_WORDS 3456
#define XB_SPIN_CAP (1u << 22)
__device__ __forceinline__ unsigned xb_ld(unsigned* p)              { return __hip_atomic_load(p, __ATOMIC_RELAXED, __HIP_MEMORY_SCOPE_AGENT); }
__device__ __forceinline__ unsigned xb_add(unsigned* p, unsigned v) { return __hip_atomic_fetch_add(p, v, __ATOMIC_RELAXED, __HIP_MEMORY_SCOPE_AGENT); }
__device__ __forceinline__ unsigned xb_xcc_id() { return (unsigned)__builtin_amdgcn_s_getreg((3 << 11) | 20) & 0xFu; }
#define XB_SPIN(cond, bar) do { unsigned _sp = 0; while (cond) { __builtin_amdgcn_s_sleep(1); \
    if ((++_sp & 255u) == 0u) { if (xb_ld(&(bar)[XB_TMO])) break; if (_sp > XB_SPIN_CAP) { atomicAdd(&(bar)[XB_TMO], 1u); break; } } } } while (0)
struct XcdBarrier { unsigned* bar; unsigned x; volatile LAS unsigned* st; };
__device__ __forceinline__ XcdBarrier xcd_barrier_post(unsigned* bar, volatile LAS unsigned* st) {
    XcdBarrier b; b.bar = bar; b.x = xb_xcc_id(); b.st = st;
    if (threadIdx.x == 0) (void)xb_add(&bar[XB_XCNT(b.x)], 1u);
    return b;
}
__device__ __forceinline__ void xcd_barrier_complete(unsigned* bar, unsigned x, unsigned& nloc, unsigned& nx) {
    const unsigned G = gridDim.x * gridDim.y * gridDim.z;
    unsigned sum, cnt, mine, sp = 0u;
    for (;;) {
        sum = 0u; cnt = 0u; mine = 0u;
#pragma unroll
        for (unsigned j = 0; j < 16; ++j) { const unsigned c = xb_ld(&bar[XB_XCNT(j)]); sum += c; cnt += (c > 0u) ? 1u : 0u; mine = (j == x) ? c : mine; }
        if (sum == G) break;
        __builtin_amdgcn_s_sleep(1);
        if ((++sp & 255u) == 0u) { if (xb_ld(&bar[XB_TMO])) break; if (sp > XB_SPIN_CAP) { atomicAdd(&bar[XB_TMO], 1u); break; } }
    }
    nloc = mine > 0u ? mine : 1u; nx = cnt > 0u ? cnt : 1u;
}
__device__ __forceinline__ void xcd_barrier(const XcdBarrier& b, bool leader) {
    asm volatile("s_waitcnt vmcnt(0)" ::: "memory");
    __syncthreads();
    if (leader) {
        unsigned* bar = b.bar;
        __builtin_amdgcn_s_waitcnt(0);
        unsigned nloc = b.st[0], nx = b.st[1];
        if (nloc == 0u) { xcd_barrier_complete(bar, b.x, nloc, nx); b.st[0] = nloc; b.st[1] = nx; }
        const unsigned old = xb_add(&bar[XB_XSUB(b.x)], 1u);
        const unsigned gen = old / nloc;
        if (old + 1u == (gen + 1u) * nloc) {
            __builtin_amdgcn_fence(__ATOMIC_RELEASE, "agent");
            asm volatile("s_waitcnt vmcnt(0)" ::: "memory");
            const unsigned og = xb_add(&bar[XB_TOP], 1u);
            const unsigned tg = og / nx;
            if (og + 1u == (tg + 1u) * nx) xb_add(&bar[XB_TOPGEN], 1u);
            else XB_SPIN(xb_ld(&bar[XB_TOPGEN]) == tg, bar);
            __builtin_amdgcn_fence(__ATOMIC_ACQUIRE, "agent");
            xb_add(&bar[XB_XGEN(b.x)], 1u);
            asm volatile("s_waitcnt vmcnt(0)" ::: "memory");
        } else {
            XB_SPIN(xb_ld(&bar[XB_XGEN(b.x)]) == gen, bar);
            __builtin_amdgcn_fence(__ATOMIC_ACQUIRE, "agent");
            asm volatile("s_waitcnt vmcnt(0)" ::: "memory");
        }
    }
    __syncthreads();
}

__device__ __forceinline__ void transpose_item(const float* W, int K, int N, bf16_t* WT, int k0, int n0, int drow0, LAS float* scr, int lane) {
#pragma unroll 8
    for (int i = 0; i < 32; ++i) { const int kk = 2 * i + (lane >> 5); scr[kk * 33 + (lane & 31)] = __builtin_nontemporal_load(W + (size_t)(k0 + kk) * N + n0 + (lane & 31)); }
    LDS_WAIT(); asm volatile("" ::: "memory");
    const int c = lane & 7;
#pragma unroll
    for (int j = 0; j < 4; ++j) { const int n = (lane >> 3) + 8 * j; const LAS float* s = scr + (8 * c) * 33 + n;
        u32x4 o; o.x = pk2(s[0 * 33], s[1 * 33]); o.y = pk2(s[2 * 33], s[3 * 33]); o.z = pk2(s[4 * 33], s[5 * 33]); o.w = pk2(s[6 * 33], s[7 * 33]);
        __builtin_nontemporal_store(o, (u32x4*)(WT + (size_t)(drow0 + n) * K + k0 + 8 * c)); }
    LDS_WAIT(); asm volatile("" ::: "memory");
}

struct WPtrs { const float *w_in, *w_out, *w_gate, *w_up, *w_down; };
#define TAIL_CONV 0
constexpr int CONV_ITEMS = (D / 64) * (INC / 32) + (D / 64) * (D / 32) + 2 * NE * (D / 64) * (DE / 32) + NE * (DE / 64) * (D / 32), CONV_SPLIT = 12288;
__device__ __forceinline__ void convert_layer(const WPtrs& W, unsigned char* ws, int l, int lo, int hi, int part, int nparts, LAS float* scr, int lane) {
    constexpr int I_IN = (D / 64) * (INC / 32), I_OUT = (D / 64) * (D / 32), I_G = (D / 64) * (DE / 32), I_D = (DE / 64) * (D / 32);
    constexpr int N_G = NE * I_G, N_D = NE * I_D;
    for (int it = lo + part; it < hi; it += nparts) {
        int r = it;
        if (r < I_IN) { const int nblk = INC / 32, kb = r / nblk, nb = r % nblk;
            transpose_item(W.w_in + (size_t)l * D * INC, D, INC, (bf16_t*)(ws + WS_WIN) + (size_t)l * INC * D, 64 * kb, 32 * nb, 32 * nb, scr, lane); continue; } r -= I_IN;
        if (r < I_OUT) { const int nblk = D / 32, kb = r / nblk, nb = r % nblk;
            transpose_item(W.w_out + (size_t)l * D * D, D, D, (bf16_t*)(ws + WS_WOUT) + (size_t)l * D * D, 64 * kb, 32 * nb, 32 * nb, scr, lane); continue; } r -= I_OUT;
        if (r < 2 * N_G) { const int up = r >= N_G; if (up) r -= N_G; const int le = l * NE + r / I_G, q = r % I_G, nblk = DE / 32, kb = q / nblk, nb = q % nblk, n0 = 32 * nb;
            transpose_item((up ? W.w_up : W.w_gate) + (size_t)le * D * DE, D, DE, (bf16_t*)(ws + WS_WGU) + (size_t)le * 1024 * D, 64 * kb, n0, (n0 >> 7) * 256 + (up ? 128 : 0) + (n0 & 127), scr, lane); continue; } r -= 2 * N_G;
        { const int le = l * NE + r / I_D, q = r % I_D, nblk = D / 32, kb = q / nblk, nb = q % nblk;
            transpose_item(W.w_down + (size_t)le * DE * D, DE, D, (bf16_t*)(ws + WS_WD) + (size_t)le * D * DE, 64 * kb, 32 * nb, 32 * nb, scr, lane); }
    }
}

struct Args { const float* in[22]; float* out; unsigned char* ws; int l_lo, l_hi, ph_lo, ph_hi, one, pad; };
enum { PH_PRO = 0, PH_NORM1 = 1, PH_PROJ = 2, PH_ATT = 3, PH_SCAN = 4, PH_HG3 = 5, PH_OUT = 6, PH_ROUTE = 7, PH_UP = 8, PH_DOWN = 9, PH_FINAL = 10 };

template <bool ROUTER>
__device__ __forceinline__ void norm_rows(const Args& args, unsigned char* ws, int l, int wg, int tid, int wave, int lane, LAS unsigned char* lds, bool addy, const float* gain, int shift_idx, int scale_idx, const float* Xp) {
    const bool dry = args.pad != 0;
    float* Xwp = (float*)(ws + (dry ? WS_DRY_X : WS_X)); const bf16_t* Y1p = (const bf16_t*)(ws + WS_Y1); bf16_t* HBp = (bf16_t*)(ws + (dry ? WS_DRY_HB : WS_HB));
    const float* modl = (const float*)(ws + WS_MOD) + (size_t)l * NB * MODW;
    int row0 = wg * 32; asm volatile("" : "+s"(row0));
    const int b = row0 / S;
    const float* sh = modl + b * MODW + shift_idx * D; const float* sc = modl + b * MODW + scale_idx * D;
    LAS float* wr = (LAS float*)lds;
    if (ROUTER) {
        const float* w_router = args.in[16];
        for (int i = tid; i < D * NE / 4; i += NTHR) { const f32x4 v = *(const f32x4*)(w_router + 4 * i); const int j = i >> 2, e = (i & 3) * 4;
            wr[(e + 0) * D + j] = v[0]; wr[(e + 1) * D + j] = v[1]; wr[(e + 2) * D + j] = v[2]; wr[(e + 3) * D + j] = v[3]; }
        __syncthreads();
    }
    f32x4 ga[8], sv[8];
#pragma unroll
    for (int j = 0; j < 8; ++j) { const int c = 4 * lane + 256 * j; const f32x4 g = *(const f32x4*)(gain + c), s1 = *(const f32x4*)(sc + c); ga[j] = g * (s1 + 1.f); sv[j] = *(const f32x4*)(sh + c); }
    for (int i = 0; i < 4; ++i) {
        const int row = row0 + wave + 8 * i;
        const float* xr = Xp + (size_t)row * D;
        f32x4 v[8]; float ss = 0.f;
#pragma unroll
        for (int j = 0; j < 8; ++j) { const int c = 4 * lane + 256 * j; v[j] = *(const f32x4*)(xr + c);
            if (addy) { const u32x2 y = *(const u32x2*)(Y1p + (size_t)row * D + c); v[j][0] += bflo(y.x); v[j][1] += bfhi(y.x); v[j][2] += bflo(y.y); v[j][3] += bfhi(y.y); *(f32x4*)(Xwp + (size_t)row * D + c) = v[j]; }
            ss += (v[j][0] * v[j][0] + v[j][1] * v[j][1]) + (v[j][2] * v[j][2] + v[j][3] * v[j][3]); }
        const float r = rsqrtf(wave_sum(ss) * (1.f / D) + EPS);
#pragma unroll
        for (int j = 0; j < 8; ++j) { const int c = 4 * lane + 256 * j; v[j] = v[j] * r * ga[j] + sv[j];
            u32x2 o; o.x = pk2(v[j][0], v[j][1]); o.y = pk2(v[j][2], v[j][3]); *(u32x2*)(HBp + (size_t)row * D + c) = o; }
        if (ROUTER) {
            float acc[NE];
#pragma unroll
            for (int e = 0; e < NE; ++e) acc[e] = 0.f;
#pragma unroll
            for (int j = 0; j < 8; ++j) {
#pragma unroll
                for (int e = 0; e < NE; ++e) { const f32x4 w = *(const LAS f32x4*)(wr + e * D + 4 * lane + 256 * j); acc[e] += (v[j][0] * w[0] + v[j][1] * w[1]) + (v[j][2] * w[2] + v[j][3] * w[3]); }
                asm volatile("" ::: "memory"); }
#pragma unroll
            for (int i = 0; i < 8; ++i) { const bool up = (lane & 32) != 0; const float snd = up ? acc[i] : acc[i + 8], kp = up ? acc[i + 8] : acc[i]; acc[i] = kp + __shfl_xor(snd, 32); }
#pragma unroll
            for (int i = 0; i < 4; ++i) { const bool up = (lane & 16) != 0; const float snd = up ? acc[i] : acc[i + 4], kp = up ? acc[i + 4] : acc[i]; acc[i] = kp + __shfl_xor(snd, 16); }
#pragma unroll
            for (int i = 0; i < 2; ++i) { const bool up = (lane & 8) != 0; const float snd = up ? acc[i] : acc[i + 2], kp = up ? acc[i + 2] : acc[i]; acc[i] = kp + __shfl_xor(snd, 8); }
            { const bool up = (lane & 4) != 0; const float snd = up ? acc[0] : acc[1], kp = up ? acc[1] : acc[0]; acc[0] = kp + __shfl_xor(snd, 4); }
            float mine = acc[0]; mine += __shfl_xor(mine, 2); mine += __shfl_xor(mine, 1);
            float p[NE];
#pragma unroll
            for (int e = 0; e < NE; ++e) p[e] = __shfl(mine, 4 * e);
            if (lane == 0) {
                const float* b_router = args.in[17];
                float m = -1e30f;
#pragma unroll
                for (int e = 0; e < NE; ++e) { p[e] += b_router[e]; m = fmaxf(m, p[e]); }
                float s = 0.f;
#pragma unroll
                for (int e = 0; e < NE; ++e) { p[e] = expf(p[e] - m); s += p[e]; }
#pragma unroll
                for (int e = 0; e < NE; ++e) p[e] /= s;
                int gs = 0; float best = -1.f;
#pragma unroll
                for (int g = 0; g < 4; ++g) { float a = -1.f, c2 = -1.f;
#pragma unroll
                    for (int q = 0; q < 4; ++q) { const float pv = p[g * 4 + q]; if (pv > a) { c2 = a; a = pv; } else if (pv > c2) c2 = pv; }
                    if (a + c2 > best) { best = a + c2; gs = g; } }
                float q4[4];
#pragma unroll
                for (int q = 0; q < 4; ++q) q4[q] = gs == 0 ? p[q] : gs == 1 ? p[4 + q] : gs == 2 ? p[8 + q] : p[12 + q];
                int e0 = -1, e1 = -1; float v0 = -2.f, v1 = -2.f;
#pragma unroll
                for (int q = 0; q < 4; ++q) { const float pv = q4[q]; if (pv > v0) { v1 = v0; e1 = e0; v0 = pv; e0 = gs * 4 + q; } else if (pv > v1) { v1 = pv; e1 = gs * 4 + q; } }
                const float den = v0 + v1;
                LAS float* rs = (LAS float*)(lds + LDS_SEL_OFF) + 4 * (row - row0);
                rs[0] = __int_as_float(e0); rs[1] = __int_as_float(e1); rs[2] = v0 / den; rs[3] = v1 / den;
            }
        }
    }
    if (ROUTER) {
        __syncthreads();
        if (tid < NE) { const int e = tid; const LAS float* rs = (const LAS float*)(lds + LDS_SEL_OFF); int n = 0;
            int* wgcnt = (int*)(ws + (dry ? WS_DRY_SMALL : WS_WGCNT)); float* wgw = (float*)(ws + (dry ? WS_DRY_SMALL + 64 * 1024 : WS_WGW)); int* wgtok = (int*)(ws + (dry ? WS_DRY_SMALL + 64 * 1024 + 512 * 1024 : WS_WGTOK));
            const int base = (wg * 16 + e) * 32;
#pragma unroll 1
            for (int r = 0; r < 32; ++r) { const int e0 = __float_as_int(rs[4 * r]), e1 = __float_as_int(rs[4 * r + 1]);
                if (e0 == e) { wgw[base + n] = rs[4 * r + 2]; wgtok[base + n] = row0 + r; ++n; }
                if (e1 == e) { wgw[base + n] = rs[4 * r + 3]; wgtok[base + n] = (row0 + r) | (int)0x80000000; ++n; } }
            wgcnt[wg * 16 + e] = n; }
    }
}

__global__ void __launch_bounds__(NTHR, 2) mk_fwd(Args args) {
    extern __shared__ __attribute__((aligned(16))) unsigned char lds_raw[];
    LAS unsigned char* lds = (LAS unsigned char*)lds_raw;
    const int G = gridDim.x, wg = blockIdx.x;
    const int wave0 = __builtin_amdgcn_readfirstlane(threadIdx.x >> 6);
    XcdBarrier bar;
    {
        const int tid = threadIdx.x; unsigned* ctl = (unsigned*)(args.ws + WS_CTL);
        volatile LAS unsigned* MISC = (volatile LAS unsigned*)(lds + MISC_OFF);
        for (int u = tid; u < (LDS_BYTES - LDSCTL_OFF) / 4; u += NTHR) ((LAS unsigned*)(lds + LDSCTL_OFF))[u] = 0u;
        __syncthreads();
        bar.bar = ctl + CW_BAR; bar.x = 0; bar.st = nullptr;
        if (args.one) bar = xcd_barrier_post(ctl + CW_BAR, MISC + 8);
    }
#define GRID_BAR() do { if (args.one) { int ln_; asm volatile("v_mbcnt_lo_u32_b32 %0, -1, 0\n\tv_mbcnt_hi_u32_b32 %0, -1, %0" : "=v"(ln_)); xcd_barrier(bar, wave0 == 0 && ln_ == 0); } } while (0)
#define IN(k) (args.ph_lo <= (k) && (k) < args.ph_hi)
#define X ((float*)(ws + WS_X))
#define HB ((bf16_t*)(ws + WS_HB))
#define P ((bf16_t*)(ws + WS_P))
#define LF ((float*)(ws + WS_LF))
#define MIX ((bf16_t*)(ws + WS_MIX))
#define ACT ((bf16_t*)(ws + WS_ACT))
#define Y1 ((bf16_t*)(ws + WS_Y1))
#define MOD ((float*)(ws + WS_MOD))
#define LB ((float*)(ws + WS_LB))
#define LAM ((float*)(ws + WS_LAM))
#define LANE_LOCALS int tid; asm volatile("v_mbcnt_lo_u32_b32 %0, -1, 0\n\tv_mbcnt_hi_u32_b32 %0, -1, %0" : "=v"(tid)); tid += wave0 * 64; const int lane = tid & 63; (void)lane;
#define PHASE_LOCALS unsigned char* ws = args.ws; asm volatile("" : "+s"(ws)); int tid; asm volatile("v_mbcnt_lo_u32_b32 %0, -1, 0\n\tv_mbcnt_hi_u32_b32 %0, -1, %0" : "=v"(tid)); tid += wave0 * 64; \
    const int lane = tid & 63, wave = wave0; (void)lane; (void)wave; unsigned* ctl = (unsigned*)(ws + WS_CTL); (void)ctl;

#ifndef NO_PRO
    if (args.l_lo == 0 && IN(PH_PRO)) { PHASE_LOCALS
        if (wg == 0) {
            for (int j = tid; j < 1024; j += NTHR) { const float* hl = args.in[13]; float v[DEPTH], m = -1e30f;
                for (int l = 0; l < DEPTH; ++l) { v[l] = hl[l * 1024 + j]; m = fmaxf(m, v[l]); }
                float s = 0.f; for (int l = 0; l < DEPTH; ++l) { v[l] = expf(v[l] - m); s += v[l]; }
                float cum = 0.f; const float s0 = v[0] / s;
                for (int l = 0; l < DEPTH; ++l) { cum += v[l] / s; LB[l * 1024 + j] = fmaxf(cum - s0, 0.f); } }
            if (tid < DEPTH) { float a = 0.f, b = 0.f;
                for (int i = 0; i < 64; ++i) { a += args.in[8][tid * 64 + i] * args.in[9][tid * 64 + i]; b += args.in[10][tid * 64 + i] * args.in[11][tid * 64 + i]; }
                LAM[tid] = expf(a) - expf(b) + (0.8f - 0.6f * expf(-0.3f * (float)tid)); }
        }
        {
            LAS float* ca = (LAS float*)lds; LAS float* red = ca + NB * D;
            for (int i = tid; i < NB * D; i += NTHR) ca[i] = siluf_(args.in[1][i]);
            __syncthreads();
            for (int item = wg; item < DEPTH * 64; item += G) {
                const int l = item >> 6, c0 = (item & 63) * 192;
                if (tid < 384) { const int cg = tid % 48, ks = tid / 48; const float* w = args.in[6] + (size_t)l * D * MODW + c0 + 4 * cg;
                    f32x4 a0 = {0.f, 0.f, 0.f, 0.f}, a1 = a0;
#pragma unroll 8
                    for (int k = ks * 256; k < ks * 256 + 256; ++k) { const f32x4 wv = *(const f32x4*)(w + (size_t)k * MODW); a0 += wv * ca[k]; a1 += wv * ca[D + k]; }
#pragma unroll
                    for (int q = 0; q < 4; ++q) { red[(ks * 2 + 0) * 192 + 4 * cg + q] = a0[q]; red[(ks * 2 + 1) * 192 + 4 * cg + q] = a1[q]; } }
                __syncthreads();
                if (tid < 384) { const int b = tid / 192, c = tid % 192; float s = args.in[7][l * MODW + c0 + c];
                    for (int ks = 0; ks < 8; ++ks) s += red[(ks * 2 + b) * 192 + c];
                    MOD[(size_t)(l * NB + b) * MODW + c0 + c] = s; }
                __syncthreads();
            }
        }
        {
            const WPtrs W{args.in[2], args.in[3], args.in[18], args.in[19], args.in[20]};
            for (int l = 0; l < DEPTH; ++l) convert_layer(W, ws, l, 0, CONV_ITEMS, wg * NWAVES + wave, G * NWAVES, (LAS float*)(lds + wave * 16384), lane);
        }
        GRID_BAR();
    }
#endif

    for (int l = args.l_lo; l < args.l_hi; ++l) {
#ifndef NO_NORM1
        if (IN(PH_NORM1)) { PHASE_LOCALS norm_rows<false>(args, ws, l, wg, tid, wave, lane, lds, l > 0, args.in[4] + l * D, 0, 1, l == 0 ? args.in[0] : (const float*)(ws + WS_X)); GRID_BAR(); }
#endif
#ifndef NO_PROJ
        if (IN(PH_PROJ)) { PHASE_LOCALS
            pg8::Gemm g{HB, (const bf16_t*)(ws + WS_WIN) + (size_t)l * INC * D, D}; pg8::StaticOrder So; So.init(T, INC, G, wg);
            pg8::EpiProj E{P, LF, LB + l * 1024};
            pg8::gemm_phase<pg8::EpiProj, pg8::StaticOrder, false>(lds, g, So, E, tid);
            { LANE_LOCALS
                const int nun = (T / 256) * (INC / 256), rounds = (nun + G - 1) / G, first_idle = nun - (rounds - 1) * G;
                if (TAIL_CONV && l + 1 < DEPTH && wg >= first_idle && first_idle < G) { const WPtrs W{args.in[2], args.in[3], args.in[18], args.in[19], args.in[20]};
                    convert_layer(W, ws, l + 1, 0, CONV_SPLIT, (wg - first_idle) * NWAVES + wave, (G - first_idle) * NWAVES, (LAS float*)(lds + wave * 16384), lane); }
                else if (TAIL_CONV && l + 1 < DEPTH && first_idle >= G) { const WPtrs W{args.in[2], args.in[3], args.in[18], args.in[19], args.in[20]};
                    convert_layer(W, ws, l + 1, 0, CONV_SPLIT, wg * NWAVES + wave, G * NWAVES, (LAS float*)(lds + wave * 16384), lane); }
            }
            GRID_BAR();
        }
#endif
        MIXER_PHASES
#ifndef NO_OUT
        if (IN(PH_OUT)) { PHASE_LOCALS const float* modl = MOD + (size_t)l * NB * MODW;
            pg8::Gemm g{MIX, (const bf16_t*)(ws + WS_WOUT) + (size_t)l * D * D, D}; pg8::StaticOrder So; So.init(T, D, G, wg);
            pg8::EpiResid E{l == 0 ? args.in[0] : (const float*)X, (float*)(ws + (args.pad ? WS_DRY_X : WS_X)), modl + 2 * D};
            pg8::gemm_phase<pg8::EpiResid, pg8::StaticOrder, false>(lds, g, So, E, tid);
            GRID_BAR();
        }
#endif
#ifndef NO_ROUTE
        if (IN(PH_ROUTE)) { PHASE_LOCALS norm_rows<true>(args, ws, l, wg, tid, wave, lane, lds, false, args.in[5] + l * D, 3, 4, (const float*)(ws + WS_X)); GRID_BAR(); }
#endif
        if (IN(PH_UP) || IN(PH_DOWN)) { PHASE_LOCALS const float* modl = MOD + (size_t)l * NB * MODW;
            LAS int* tb = (LAS int*)(lds + LDS_TB_OFF); LAS int* pre = (LAS int*)(lds + LDS_PRE_OFF);
            {
                const int* wgcnt = (const int*)(ws + WS_WGCNT);
#pragma unroll 1
                for (int k = 0; k < 2; ++k) { const int e = 2 * wave + k; int c4[4], sum = 0;
#pragma unroll
                    for (int q = 0; q < 4; ++q) { c4[q] = wgcnt[(4 * lane + q) * 16 + e]; sum += c4[q]; }
                    int inc = sum;
#pragma unroll
                    for (int o = 1; o < 64; o <<= 1) { const int t2 = __shfl_up(inc, o); if (lane >= o) inc += t2; }
                    int run = inc - sum;
#pragma unroll
                    for (int q = 0; q < 4; ++q) { pre[e * 257 + 4 * lane + q] = run; run += c4[q]; }
                    if (lane == 63) pre[e * 257 + 256] = run; }
                __syncthreads();
                if (tid == 0) { int a = 0; for (int e = 0; e < NE; ++e) { const int n = pre[e * 257 + 256]; tb[e] = a; tb[17 + e] = n; a += (n + 255) >> 8; } tb[16] = a; }
                __syncthreads();
            }
#ifndef NO_UP
            if (IN(PH_UP)) { LANE_LOCALS
                pg8::Gemm g{HB, (const bf16_t*)(ws + WS_WGU) + (size_t)l * NE * 1024 * D, D}; pg8::MoeOrder So{tb, pre, (const int*)(ws + WS_WGTOK), 4, G, wg};
                pg8::EpiMoeUp E{ACT, (const float*)(ws + WS_WGW), pre};
                pg8::gemm_phase<pg8::EpiMoeUp, pg8::MoeOrder, true>(lds, g, So, E, tid);
                if (TAIL_CONV && l + 1 < DEPTH) { LANE_LOCALS
                    const int nun = tb[16] * 4, rounds = (nun + G - 1) / G, first_idle = nun - (rounds - 1) * G; const WPtrs W{args.in[2], args.in[3], args.in[18], args.in[19], args.in[20]};
                    if (first_idle < G) { if (wg >= first_idle) convert_layer(W, ws, l + 1, CONV_SPLIT, CONV_ITEMS, (wg - first_idle) * NWAVES + wave, (G - first_idle) * NWAVES, (LAS float*)(lds + wave * 16384), lane); }
                    else convert_layer(W, ws, l + 1, CONV_SPLIT, CONV_ITEMS, wg * NWAVES + wave, G * NWAVES, (LAS float*)(lds + wave * 16384), lane); }
                GRID_BAR();
            }
#endif
#ifndef NO_DOWN
            if (IN(PH_DOWN)) { LANE_LOCALS
                pg8::Gemm g{ACT, (const bf16_t*)(ws + WS_WD) + (size_t)l * NE * D * DE, DE}; pg8::MoeOrder So{tb, pre, (const int*)(ws + WS_WGTOK), 8, G, wg};
                pg8::EpiMoeDown E{X, (float*)(ws + (args.pad ? WS_DRY_X : WS_X)), (bf16_t*)(ws + (args.pad ? WS_DRY_Y1 : WS_Y1)), modl + 5 * D, (const int*)(ws + WS_WGTOK), pre};
                pg8::gemm_phase<pg8::EpiMoeDown, pg8::MoeOrder, false>(lds, g, So, E, tid);
                GRID_BAR();
            }
#endif
        }
    }
    if (args.l_hi == DEPTH && IN(PH_FINAL)) { PHASE_LOCALS
        const int row0 = wg * 32; const float* gain = args.in[21];
        f32x4 ga[8];
#pragma unroll
        for (int j = 0; j < 8; ++j) ga[j] = *(const f32x4*)(gain + 4 * lane + 256 * j);
        for (int i = 0; i < 4; ++i) { const int row = row0 + wave + 8 * i; const float* xr = X + (size_t)row * D; f32x4 v[8]; float ss = 0.f;
#pragma unroll
            for (int j = 0; j < 8; ++j) { const int c = 4 * lane + 256 * j; v[j] = *(const f32x4*)(xr + c); const u32x2 y = *(const u32x2*)(Y1 + (size_t)row * D + c);
                v[j][0] += bflo(y.x); v[j][1] += bfhi(y.x); v[j][2] += bflo(y.y); v[j][3] += bfhi(y.y); ss += (v[j][0] * v[j][0] + v[j][1] * v[j][1]) + (v[j][2] * v[j][2] + v[j][3] * v[j][3]); }
            const float r = rsqrtf(wave_sum(ss) * (1.f / D) + EPS);
#pragma unroll
            for (int j = 0; j < 8; ++j) *(f32x4*)(args.out + (size_t)row * D + 4 * lane + 256 * j) = v[j] * r * ga[j]; }
    }
#undef GRID_BAR
#undef IN
#undef X
#undef HB
#undef P
#undef LF
#undef MIX
#undef ACT
#undef Y1
#undef MOD
#undef LB
#undef LAM
}
__global__ void __launch_bounds__(256) s_attn(const bf16_t* P, const float* rel_bias, const float* lam_p, const float* subln, int layer, bf16_t* MIX) {
    __shared__ float qv[128], s1[S], s2[S], red[8], ob[2][128];
    const int q = blockIdx.x, h = blockIdx.y, b = blockIdx.z, tid = threadIdx.x;
    const size_t rowq = (size_t)(b * S + q) * INC;
    if (tid < 128) qv[tid] = bf2f(P[rowq + C_QD + h * 128 + tid]);
    __syncthreads();
    const int nk = q + 1;
    float m1 = -1e30f, m2 = -1e30f;
    for (int k = tid; k < nk; k += 256) {
        const bf16_t* kr = P + (size_t)(b * S + k) * INC + C_KD + h * 128;
        float d1 = 0.f, d2 = 0.f;
        for (int i = 0; i < 64; ++i) { d1 += qv[i] * bf2f(kr[i]); d2 += qv[64 + i] * bf2f(kr[64 + i]); }
        const int n = q - k; const int bk = n < 128 ? (int)T5B[n] : 31;
        d1 += rel_bias[bk * 16 + 2 * h] * LOG2E; d2 += rel_bias[bk * 16 + 2 * h + 1] * LOG2E;
        s1[k] = d1; s2[k] = d2; m1 = fmaxf(m1, d1); m2 = fmaxf(m2, d2);
    }
    m1 = block_max256(m1, red); m2 = block_max256(m2, red);
    float l1 = 0.f, l2 = 0.f;
    for (int k = tid; k < nk; k += 256) { const float e1 = exp2f(s1[k] - m1), e2 = exp2f(s2[k] - m2); s1[k] = e1; s2[k] = e2; l1 += e1; l2 += e2; }
    l1 = block_sum256(l1, red); l2 = block_sum256(l2, red);
    const float lam = lam_p[layer]; const float i1 = 1.f / l1, i2 = lam / l2;
    const int d = tid & 127, half = tid >> 7;
    float acc = 0.f;
    for (int k = half; k < nk; k += 2) acc += (s1[k] * i1 - s2[k] * i2) * bf2f(P[(size_t)(b * S + k) * INC + C_VD + h * 128 + d]);
    ob[half][d] = acc;
    __syncthreads();
    float o = 0.f;
    if (tid < 128) o = ob[0][tid] + ob[1][tid];
    const float ss = block_sum256(tid < 128 ? o * o : 0.f, red);
    const float lambda_init = 0.8f - 0.6f * expf(-0.3f * (float)layer);
    if (tid < 128) MIX[(size_t)(b * S + q) * D + h * 128 + tid] = (bf16_t)f2bf(o * rsqrtf(ss / 128.f + EPS) * subln[layer * 128 + tid] * (1.f - lambda_init));
}
__global__ void __launch_bounds__(128) s_hgrn(const bf16_t* P, const float* LF, float* hraw) {
    __shared__ float red[2][2][8];
    const int js = blockIdx.x, h = blockIdx.y, b = blockIdx.z, d = threadIdx.x, w = d >> 6;
    float St[8];
    for (int i = 0; i < 8; ++i) St[i] = 0.f;
    for (int t = 0; t < S; ++t) {
        const size_t row = (size_t)(b * S + t);
        const bf16_t* pr = P + row * INC;
        const float f = expf(LF[row * 1024 + h * 128 + d]), kk = bf2f(pr[C_FH + h * 128 + d]), qq = bf2f(pr[C_QH + h * 128 + d]);
        float part[8];
        for (int i = 0; i < 8; ++i) { const float vv = bf2f(pr[C_IH + h * 128 + js * 8 + i]); St[i] = f * St[i] + kk * vv; part[i] = wave_sum(qq * St[i]); }
        if ((d & 63) == 0) for (int i = 0; i < 8; ++i) red[t & 1][w][i] = part[i];
        __syncthreads();
        if (d < 8) hraw[row * 1024 + h * 128 + js * 8 + d] = red[t & 1][0][d] + red[t & 1][1][d];
    }
}
__global__ void __launch_bounds__(256) s_hgrn_post(const float* hraw, const bf16_t* P, const float* hnorm_l, bf16_t* MIX) {
    const int t = blockIdx.x, tid = threadIdx.x;
    float v[4]; float ss = 0.f;
    for (int i = 0; i < 4; ++i) { v[i] = hraw[(size_t)t * 1024 + tid * 4 + i]; ss += v[i] * v[i]; }
    for (int o = 1; o < 32; o <<= 1) ss += __shfl_xor(ss, o);
    const float r = rsqrtf(ss / 128.f + EPS);
    for (int i = 0; i < 4; ++i) { const int j = tid * 4 + i; const float sg = bf2f(P[(size_t)t * INC + C_GH + j]); MIX[(size_t)t * D + 1024 + j] = (bf16_t)f2bf(v[i] * r * hnorm_l[j & 127] * sg); }
}
#ifndef PROBE_REP
#define PROBE_REP -1
#endif
extern "C" void kernel_launch(void* const* d_in, const int* in_sizes, int n_in, void* d_out, int out_size, void* d_ws, size_t ws_size, hipStream_t stream) {
    static int grid = 0;
    if (grid == 0) {
        if (n_in != 22 || in_sizes[0] != T * D || out_size != T * D || ws_size < WS_END2) { fprintf(stderr, "kernel_launch: unexpected shapes / workspace (%d inputs, ws %zu, need %zu)\n", n_in, ws_size, (size_t)WS_END); grid = -1; return; }
        int dev = 0, cus = 0;
        if (hipGetDevice(&dev) != hipSuccess || hipDeviceGetAttribute(&cus, hipDeviceAttributeMultiprocessorCount, dev) != hipSuccess) { grid = -1; return; }
        if (hipFuncSetAttribute((const void*)mk_fwd, hipFuncAttributeMaxDynamicSharedMemorySize, LDS_BYTES) != hipSuccess) { fprintf(stderr, "kernel_launch: hipFuncSetAttribute failed\n"); grid = -1; return; }
        int per_cu = 0;
        if (hipOccupancyMaxActiveBlocksPerMultiprocessor(&per_cu, (const void*)mk_fwd, NTHR, LDS_BYTES) != hipSuccess || per_cu < 1) fprintf(stderr, "kernel_launch: occupancy query reports %d\n", per_cu);
        (void)hipGetLastError();
        grid = cus < 256 ? cus : 256;
        if (grid != 256) fprintf(stderr, "kernel_launch: %d CUs; this kernel is laid out for 256\n", cus);
    }
    if (grid < 0) return;
    (void)hipMemsetAsync((char*)d_ws + WS_CTL, 0, CTL_ZERO_BYTES, stream);
    Args a{};
    for (int i = 0; i < 22; ++i) a.in[i] = (const float*)d_in[i];
    a.out = (float*)d_out; a.ws = (unsigned char*)d_ws;
    unsigned char* ws = (unsigned char*)d_ws;
    auto mk = [&](int l_lo, int l_hi, int ph_lo, int ph_hi, int one) {
        a.l_lo = l_lo; a.l_hi = l_hi; a.ph_lo = ph_lo; a.ph_hi = ph_hi; a.one = one; a.pad = 0;
        if (!one && ph_lo == PROBE_REP) { a.pad = 1; hipLaunchKernelGGL(mk_fwd, dim3(grid), dim3(NTHR), LDS_BYTES, stream, a); a.pad = 0; }
        hipLaunchKernelGGL(mk_fwd, dim3(grid), dim3(NTHR), LDS_BYTES, stream, a);
    };
#if MK_ONE
    mk(0, DEPTH, 0, 11, 1);
#else
    mk(0, 0, PH_PRO, PH_PRO + 1, 0);
    for (int l = 0; l < DEPTH; ++l) {
        mk(l, l + 1, PH_NORM1, PH_NORM1 + 1, 0);
        mk(l, l + 1, PH_PROJ, PH_PROJ + 1, 0);
        mk(l, l + 1, PH_ATT, PH_ATT + 1, 0);
        mk(l, l + 1, PH_SCAN, PH_SCAN + 1, 0);
        mk(l, l + 1, PH_HG3, PH_HG3 + 1, 0);
        mk(l, l + 1, PH_OUT, PH_OUT + 1, 0);
        mk(l, l + 1, PH_ROUTE, PH_ROUTE + 1, 0);
        mk(l, l + 1, PH_UP, PH_UP + 1, 0);
        mk(l, l + 1, PH_DOWN, PH_DOWN + 1, 0);
    }
    mk(DEPTH, DEPTH, PH_FINAL, PH_FINAL + 1, 0);
#endif
}
```
